# Optimizing an MI355X kernel written in HIP

```python
import math
import jax, jax.numpy as jnp
from jax import lax
import numpy as np

D_MODEL = 1024
BATCH = 32
SEQ = 2048
DEPTH = 2

CTX_LEN = 256
GRID_W = 64
CHUNK = 128
GM_GROUPS = 4
GM_GDIM = 128
GM_WIDTH = GM_GROUPS * GM_GDIM
HEAD_DIM = 128
N_Q_HEADS = 4
N_KV_HEADS = 2
Q_PER_KV = N_Q_HEADS // N_KV_HEADS
ATTN_WIDTH = N_Q_HEADS * HEAD_DIM
KV_W = N_KV_HEADS * HEAD_DIM
ROPE_THETA = 10000.0
FN_GROUPS = 4
FN_GDIM = 128
FN_WIDTH = FN_GROUPS * FN_GDIM
SSD_HEADDIM = 64
SSD_HEADS = 8
SSD_GROUPS = 2
SSD_HPG = SSD_HEADS // SSD_GROUPS
SSD_STATE = 128
SSD_WIDTH = SSD_HEADS * SSD_HEADDIM
SSD_GN = SSD_GROUPS * SSD_STATE
SSD_CONV_DIM = SSD_WIDTH + 2 * SSD_GN
D_FF = 2816
CONV_W = 3
KV_OFF = 2 * GM_WIDTH + ATTN_WIDTH
AB_IN = KV_OFF + 2 * KV_W
AB_OUT = GM_WIDTH + ATTN_WIDTH
SSM_OFF = FN_WIDTH + SSD_WIDTH
CD_IN = SSM_OFF + SSD_CONV_DIM + 2 * SSD_HEADS
CD_OUT = FN_WIDTH + SSD_WIDTH
N_EVEN = (DEPTH + 1) // 2
N_ODD = DEPTH // 2
DN_ALPHA = (2 * DEPTH) ** 0.25
DN_BETA = (8 * DEPTH) ** -0.25
EPS = 1e-6

kernel_name = 'hybrid_gmlp_gqa_fnet_ssd_dit_block'


def layer_norm(x, g, b):
    xf = x.astype(jnp.float32)
    mu = jnp.mean(xf, axis=-1, keepdims=True)
    xc = xf - mu
    var = jnp.mean(xc * xc, axis=-1, keepdims=True)
    return (xc * lax.rsqrt(var + EPS) * g + b).astype(x.dtype)


def rms_norm(x, g):
    xf = x.astype(jnp.float32)
    return (xf * lax.rsqrt(jnp.mean(xf * xf, axis=-1, keepdims=True) + EPS) * g).astype(x.dtype)


def modulate(x, shift, scale):
    return x * (1 + scale) + shift


def dwconv(x, w, b):
    L = x.shape[1]
    pad = CONV_W // 2
    xp = jnp.pad(x, ((0, 0), (pad, pad), (0, 0)))
    out = b
    for k in range(CONV_W):
        out = out + xp[:, k:k + L] * w[k]
    return out


def rope_tables(L):
    rows = L // GRID_W
    row = jnp.repeat(jnp.arange(rows, dtype=jnp.float32), GRID_W)
    col = jnp.broadcast_to(jnp.arange(GRID_W, dtype=jnp.float32), (rows, GRID_W)).reshape(-1)
    n_freq = HEAD_DIM // 4
    inv = ROPE_THETA ** (-jnp.arange(n_freq, dtype=jnp.float32) / n_freq)
    ang = jnp.stack([row, col], axis=-1)[:, :, None] * inv
    return jnp.cos(ang), jnp.sin(ang)


def apply_rope(x, cos, sin):
    xf = x.astype(jnp.float32).reshape(x.shape[:-1] + (2, 2, HEAD_DIM // 4))
    x1, x2 = xf[..., 0, :], xf[..., 1, :]
    c = cos[None, :, None]
    s = sin[None, :, None]
    out = jnp.stack([x1 * c - x2 * s, x2 * c + x1 * s], axis=-2)
    return out.reshape(x.shape).astype(x.dtype)


def attend(q, k, v):
    s = jnp.einsum('bqkgd,bskd->bkgqs', q, k).astype(jnp.float32)
    p = jax.nn.softmax(s, axis=-1).astype(v.dtype)
    return jnp.einsum('bkgqs,bskd->bqkgd', p, v)


def blocked_attention(q, k, v):
    Bn, L = q.shape[:2]
    nb = L // CHUNK
    qb = (q * HEAD_DIM ** -0.5).reshape(Bn, nb, CHUNK, N_KV_HEADS, Q_PER_KV, HEAD_DIM)
    qb = jnp.moveaxis(qb, 1, 0)
    ob = lax.map(lambda qq: attend(qq, k, v), qb)
    return jnp.moveaxis(ob, 0, 1).reshape(Bn, L, ATTN_WIDTH)


def chunk_gmlp(u, v, ln_g, ln_b, ws, bs):
    u = jax.nn.gelu(u)
    v = layer_norm(jax.nn.gelu(v), ln_g, ln_b)
    Bn, L, _ = v.shape
    vr = v.reshape(Bn, L // CHUNK, CHUNK, GM_GROUPS, GM_GDIM)
    mixed = jnp.einsum('gpq,bnqgd->bnpgd', ws, vr) + bs.T[:, :, None]
    return u * mixed.reshape(Bn, L, GM_WIDTH)


def fourier_mix(h):
    Bn, L, _ = h.shape
    hf = h.astype(jnp.float32).reshape(Bn, L, FN_GROUPS, FN_GDIM)
    out = jnp.fft.fft2(hf, axes=(1, 3), norm='ortho').real
    return out.reshape(Bn, L, FN_WIDTH).astype(h.dtype)


def ssd_inputs(p, conv_w, conv_b, dt_bias):
    Bn, L = p.shape[:2]
    xbc = jax.nn.silu(dwconv(p[..., :SSD_CONV_DIM], conv_w, conv_b))
    xs = xbc[..., :SSD_WIDTH].reshape(Bn, L, SSD_GROUPS, SSD_HPG, SSD_HEADDIM)
    bm = xbc[..., SSD_WIDTH:SSD_WIDTH + SSD_GN].reshape(Bn, L, SSD_GROUPS, SSD_STATE)
    cm = xbc[..., SSD_WIDTH + SSD_GN:].reshape(Bn, L, SSD_GROUPS, SSD_STATE)
    dt = jax.nn.softplus(p[..., SSD_CONV_DIM:].astype(jnp.float32).reshape(Bn, L, 2, SSD_GROUPS, SSD_HPG)
                         + dt_bias.astype(jnp.float32).reshape(2, SSD_GROUPS, SSD_HPG))
    return xs, bm, cm, dt[:, :, 0], dt[:, :, 1]


def ssd_scan(x, dt, a, bm, cm, h0, with_y):
    Bn, L = x.shape[:2]
    nc = L // CHUNK
    xc = x.reshape(Bn, nc, CHUNK, SSD_GROUPS, SSD_HPG, SSD_HEADDIM)
    dtc = dt.reshape(Bn, nc, CHUNK, SSD_GROUPS, SSD_HPG)
    bc = bm.reshape(Bn, nc, CHUNK, SSD_GROUPS, SSD_STATE)
    cc = cm.reshape(Bn, nc, CHUNK, SSD_GROUPS, SSD_STATE)
    a_cum = jnp.cumsum(dtc * a, axis=2)
    xdt = xc * dtc[..., None]
    to_end = jnp.exp(a_cum[:, :, -1:] - a_cum)
    states = jnp.einsum('bcsgn,bcsgjp->bcgjpn', bc, xdt * to_end[..., None])
    chunk_decay = jnp.exp(a_cum[:, :, -1])

    def step(h, inp):
        dec, st = inp
        return h * dec[..., None, None] + st, h

    h_final, h_in = lax.scan(step, h0, (jnp.moveaxis(chunk_decay, 1, 0), jnp.moveaxis(states, 1, 0)))
    if not with_y:
        return None, h_final
    h_in = jnp.moveaxis(h_in, 0, 1)
    seg = a_cum[:, :, :, None] - a_cum[:, :, None]
    mask = jnp.tril(jnp.ones((CHUNK, CHUNK), dtype=bool))[:, :, None, None]
    decay = jnp.exp(jnp.where(mask, seg, -jnp.inf))
    m = jnp.einsum('bctgn,bcsgn->bctsg', cc, bc)[..., None] * decay
    y_diag = jnp.einsum('bctsgj,bcsgjp->bctgjp', m, xdt)
    y_off = jnp.einsum('bctgn,bcgjpn->bctgjp', cc, h_in) * jnp.exp(a_cum)[..., None]
    return (y_diag + y_off).reshape(Bn, L, SSD_GROUPS, SSD_HPG, SSD_HEADDIM), h_final


def ssd_out(xs, y_f, y_b, z, d_skip, norm_g):
    Bn, L = xs.shape[:2]
    y = y_f + y_b + xs.astype(jnp.float32) * d_skip.astype(jnp.float32).reshape(SSD_GROUPS, SSD_HPG, 1)
    y = y.reshape(Bn, L, SSD_WIDTH) * jax.nn.silu(z.astype(jnp.float32))
    return rms_norm(y, norm_g).astype(z.dtype)


def flip(t):
    return jnp.flip(t, axis=1)


def ab_mixer(h_l, h_c, w_in, w_out, gm_ln_g, gm_ln_b, gm_ws, gm_bs, q_norm_g, k_norm_g, cos, sin, with_ctx_out):
    Bn, L, _ = h_l.shape
    Lc = h_c.shape[1]
    p_l = h_l @ w_in
    p_c = h_c @ (w_in if with_ctx_out else w_in[:, KV_OFF:])
    kv_c = p_c[..., KV_OFF:] if with_ctx_out else p_c
    k_c = rms_norm(kv_c[..., :KV_W].reshape(Bn, Lc, N_KV_HEADS, HEAD_DIM), k_norm_g)
    v_c = kv_c[..., KV_W:].reshape(Bn, Lc, N_KV_HEADS, HEAD_DIM)
    q_l = apply_rope(rms_norm(p_l[..., 2 * GM_WIDTH:KV_OFF].reshape(Bn, L, N_Q_HEADS, HEAD_DIM), q_norm_g), cos, sin)
    k_l = apply_rope(rms_norm(p_l[..., KV_OFF:KV_OFF + KV_W].reshape(Bn, L, N_KV_HEADS, HEAD_DIM), k_norm_g), cos, sin)
    v_l = p_l[..., KV_OFF + KV_W:].reshape(Bn, L, N_KV_HEADS, HEAD_DIM)
    k_all = jnp.concatenate([k_c, k_l], axis=1)
    v_all = jnp.concatenate([v_c, v_l], axis=1)
    o_l = blocked_attention(q_l, k_all, v_all)
    a_l = chunk_gmlp(p_l[..., :GM_WIDTH], p_l[..., GM_WIDTH:2 * GM_WIDTH], gm_ln_g, gm_ln_b, gm_ws, gm_bs)
    out_l = jnp.concatenate([a_l, o_l], axis=-1) @ w_out
    if not with_ctx_out:
        return out_l, None
    q_c = rms_norm(p_c[..., 2 * GM_WIDTH:KV_OFF].reshape(Bn, Lc, N_Q_HEADS, HEAD_DIM), q_norm_g) * HEAD_DIM ** -0.5
    o_c = attend(q_c.reshape(Bn, Lc, N_KV_HEADS, Q_PER_KV, HEAD_DIM), k_c, v_c).reshape(Bn, Lc, ATTN_WIDTH)
    a_c = chunk_gmlp(p_c[..., :GM_WIDTH], p_c[..., GM_WIDTH:2 * GM_WIDTH], gm_ln_g, gm_ln_b, gm_ws, gm_bs)
    out_c = jnp.concatenate([a_c, o_c], axis=-1) @ w_out
    return out_l, out_c


def cd_mixer(h_l, h_c, w_in, w_out, conv_w, conv_b, dt_bias, a_log, d_skip, norm_g, with_ctx_out):
    Bn = h_l.shape[0]
    p_l = h_l @ w_in
    p_c = h_c @ (w_in if with_ctx_out else w_in[:, SSM_OFF:])
    ssm_c = p_c[..., SSM_OFF:] if with_ctx_out else p_c
    a = -jnp.exp(a_log.astype(jnp.float32)).reshape(2, SSD_GROUPS, SSD_HPG)
    h0 = jnp.zeros((Bn, SSD_GROUPS, SSD_HPG, SSD_HEADDIM, SSD_STATE), jnp.float32)
    x_c, b_c, c_c, dtf_c, dtb_c = ssd_inputs(ssm_c, conv_w, conv_b, dt_bias)
    yf_c, hf = ssd_scan(x_c, dtf_c, a[0], b_c, c_c, h0, with_ctx_out)
    yb_c, hb = ssd_scan(flip(x_c), flip(dtb_c), a[1], flip(b_c), flip(c_c), h0, with_ctx_out)
    x_l, b_l, c_l, dtf_l, dtb_l = ssd_inputs(p_l[..., SSM_OFF:], conv_w, conv_b, dt_bias)
    yf_l, _ = ssd_scan(x_l, dtf_l, a[0], b_l, c_l, hf, True)
    yb_l, _ = ssd_scan(flip(x_l), flip(dtb_l), a[1], flip(b_l), flip(c_l), hb, True)
    s_l = ssd_out(x_l, yf_l, flip(yb_l), p_l[..., FN_WIDTH:SSM_OFF], d_skip, norm_g)
    out_l = jnp.concatenate([fourier_mix(p_l[..., :FN_WIDTH]), s_l], axis=-1) @ w_out
    if not with_ctx_out:
        return out_l, None
    s_c = ssd_out(x_c, yf_c, flip(yb_c), p_c[..., FN_WIDTH:SSM_OFF], d_skip, norm_g)
    out_c = jnp.concatenate([fourier_mix(p_c[..., :FN_WIDTH]), s_c], axis=-1) @ w_out
    return out_l, out_c


def conv_ffn(h, w_up, conv_w, conv_b, w_down):
    a = dwconv(h @ w_up, conv_w, conv_b)
    return (a[..., :D_FF] * jax.nn.silu(a[..., D_FF:])) @ w_down


def setup_inputs(seed: int = 0) -> dict:
    key = jax.random.key(seed)
    ks = iter(jax.random.split(key, 40))

    def nrm(shape, scale):
        return jax.random.normal(next(ks), shape, jnp.float32) * scale

    def gain(shape):
        return 1.0 + nrm(shape, 0.02)

    dt0 = jnp.exp(jax.random.uniform(next(ks), (N_ODD, 2, SSD_HEADS), jnp.float32,
                                     minval=math.log(1e-3), maxval=math.log(1e-1)))
    dt_bias = dt0 + jnp.log(-jnp.expm1(-dt0))
    a_log = jnp.log(jax.random.uniform(next(ks), (N_ODD, 2, SSD_HEADS), jnp.float32, minval=1.0, maxval=16.0))
    return {
        'x': nrm((BATCH, SEQ, D_MODEL), 1.0),
        'c': nrm((BATCH, D_MODEL), 1.0),
        'ctx': nrm((BATCH, CTX_LEN, D_MODEL), 1.0),
        'c_ctx': nrm((D_MODEL,), 1.0),
        'mod_w': nrm((DEPTH, D_MODEL, 6 * D_MODEL), D_MODEL ** -0.5),
        'mod_b': nrm((DEPTH, 6 * D_MODEL), 0.01),
        'ln1_g': gain((DEPTH, D_MODEL)),
        'ln1_b': nrm((DEPTH, D_MODEL), 0.02),
        'ln2_g': gain((DEPTH, D_MODEL)),
        'ln2_b': nrm((DEPTH, D_MODEL), 0.02),
        'ffn_up': nrm((DEPTH, D_MODEL, 2 * D_FF), D_MODEL ** -0.5),
        'ffn_conv_w': nrm((DEPTH, CONV_W, 2 * D_FF), CONV_W ** -0.5),
        'ffn_conv_b': nrm((DEPTH, 2 * D_FF), 0.02),
        'ffn_down': nrm((DEPTH, D_FF, D_MODEL), DN_BETA * D_FF ** -0.5),
        'ab_w_in': nrm((N_EVEN, D_MODEL, AB_IN), D_MODEL ** -0.5),
        'ab_w_out': nrm((N_EVEN, AB_OUT, D_MODEL), DN_BETA * AB_OUT ** -0.5),
        'gm_ln_g': gain((N_EVEN, GM_WIDTH)),
        'gm_ln_b': nrm((N_EVEN, GM_WIDTH), 0.02),
        'gm_ws': nrm((N_EVEN, GM_GROUPS, CHUNK, CHUNK), CHUNK ** -0.5),
        'gm_bs': gain((N_EVEN, GM_GROUPS, CHUNK)),
        'q_norm_g': gain((N_EVEN, HEAD_DIM)),
        'k_norm_g': gain((N_EVEN, HEAD_DIM)),
        'cd_w_in': nrm((N_ODD, D_MODEL, CD_IN), D_MODEL ** -0.5),
        'cd_w_out': nrm((N_ODD, CD_OUT, D_MODEL), DN_BETA * CD_OUT ** -0.5),
        'ssd_conv_w': nrm((N_ODD, CONV_W, SSD_CONV_DIM), CONV_W ** -0.5),
        'ssd_conv_b': nrm((N_ODD, SSD_CONV_DIM), 0.02),
        'ssd_dt_bias': dt_bias,
        'ssd_a_log': a_log,
        'ssd_d': gain((N_ODD, SSD_HEADS)),
        'ssd_norm_g': gain((N_ODD, SSD_WIDTH)),
    }


def reference(x, c, ctx, c_ctx, mod_w, mod_b, ln1_g, ln1_b, ln2_g, ln2_b,
              ffn_up, ffn_conv_w, ffn_conv_b, ffn_down,
              ab_w_in, ab_w_out, gm_ln_g, gm_ln_b, gm_ws, gm_bs, q_norm_g, k_norm_g,
              cd_w_in, cd_w_out, ssd_conv_w, ssd_conv_b, ssd_dt_bias, ssd_a_log, ssd_d, ssd_norm_g):
    L = x.shape[1]
    cos, sin = rope_tables(L)
    c_act = jax.nn.silu(c)
    ctx_act = jax.nn.silu(c_ctx)
    xl, xc = x, ctx
    for i in range(DEPTH):
        last = i == DEPTH - 1
        j = i // 2
        mod_l = (c_act @ mod_w[i] + mod_b[i])[:, None, :]
        mod_c = ctx_act @ mod_w[i] + mod_b[i]
        sh1, sc1, g1, sh2, sc2, g2 = jnp.split(mod_l, 6, axis=-1)
        csh1, csc1, cg1, csh2, csc2, cg2 = jnp.split(mod_c, 6, axis=-1)
        h_l = modulate(xl, sh1, sc1)
        h_c = modulate(xc, csh1, csc1)
        if i % 2 == 0:
            out_l, out_c = ab_mixer(h_l, h_c, ab_w_in[j], ab_w_out[j], gm_ln_g[j], gm_ln_b[j], gm_ws[j], gm_bs[j],
                                    q_norm_g[j], k_norm_g[j], cos, sin, not last)
        else:
            out_l, out_c = cd_mixer(h_l, h_c, cd_w_in[j], cd_w_out[j], ssd_conv_w[j], ssd_conv_b[j],
                                    ssd_dt_bias[j], ssd_a_log[j], ssd_d[j], ssd_norm_g[j], not last)
        xl = layer_norm(DN_ALPHA * xl + g1 * out_l, ln1_g[i], ln1_b[i])
        f_l = conv_ffn(modulate(xl, sh2, sc2), ffn_up[i], ffn_conv_w[i], ffn_conv_b[i], ffn_down[i])
        xl = layer_norm(DN_ALPHA * xl + g2 * f_l, ln2_g[i], ln2_b[i])
        if not last:
            xc = layer_norm(DN_ALPHA * xc + cg1 * out_c, ln1_g[i], ln1_b[i])
            f_c = conv_ffn(modulate(xc, csh2, csc2), ffn_up[i], ffn_conv_w[i], ffn_conv_b[i], ffn_down[i])
            xc = layer_norm(DN_ALPHA * xc + cg2 * f_c, ln2_g[i], ln2_b[i])
    return xl
```

```cpp
#include <hip/hip_runtime.h>
#include <hip/hip_cooperative_groups.h>
#include <cstdio>
#include <cstdint>
namespace cg = cooperative_groups;

#ifndef MK_MULTI
#define MK_MULTI 0
#endif

#define LAS __attribute__((address_space(3)))
typedef unsigned short bf16_t;
typedef short bf16x8 __attribute__((ext_vector_type(8)));
typedef short s16x4 __attribute__((ext_vector_type(4)));
typedef float f32x4 __attribute__((ext_vector_type(4)));
typedef float f32x2 __attribute__((ext_vector_type(2)));
typedef float f32x16 __attribute__((ext_vector_type(16)));
typedef unsigned u32x4 __attribute__((ext_vector_type(4)));
typedef unsigned u32x2 __attribute__((ext_vector_type(2)));

constexpr int DM = 1024, NB = 32, SEQ = 2048, CTXL = 256, SPB = 2304  , NROWS = NB * SPB, NTILE = NROWS / 256;
constexpr int DFF = 2816, DFF2 = 5632;
constexpr float EPSN = 1e-6f, DN_ALPHA = 1.41421356237309515f;
constexpr int NT = 512, LDS_BYTES = 144 * 1024;

constexpr size_t SZ_W0IN = (size_t)2048 * 1024 * 2, SZ_SQ = (size_t)1024 * 1024 * 2, SZ_WUP = (size_t)DFF2 * 1024 * 2, SZ_WDN = (size_t)1024 * DFF * 2;
constexpr size_t WS_W0IN = 0, WS_W0OUT = WS_W0IN + SZ_W0IN, WS_WUP0 = WS_W0OUT + SZ_SQ, WS_WUP1 = WS_WUP0 + SZ_WUP, WS_WDN0 = WS_WUP1 + SZ_WUP, WS_WDN1 = WS_WDN0 + SZ_WDN;
constexpr size_t WS_W1F = WS_WDN1 + SZ_WDN, WS_W1IN = WS_W1F + SZ_SQ, WS_W1OUT = WS_W1IN + (size_t)1792 * 1024 * 2, WS_DFT = WS_W1OUT + SZ_SQ;
constexpr size_t WS_GWS = WS_DFT + (size_t)2048 * 4096 * 2, WS_ROPE = WS_GWS + (size_t)4 * 128 * 128 * 2, WS_MODP = WS_ROPE + (size_t)64 * 32 * 8, WS_MOD = WS_MODP + (size_t)4 * 2 * 33 * 6144 * 4;
constexpr size_t WS_XL = WS_MOD + (size_t)2 * 33 * 6144 * 4, WS_HA = WS_XL + (size_t)NROWS * 1024 * 4, WS_R = WS_HA + (size_t)NROWS * 1024 * 2;
constexpr int CHUNK_ROWS_MAX = 11 * SPB;
constexpr size_t R_PB = 0;
constexpr size_t R_G = 0, R_HBND = R_G + (size_t)NROWS * DFF * 2, R_PBND = R_HBND + (size_t)512 * 1024 * 2;
constexpr size_t R_P1 = 0, R_YT = R_P1 + (size_t)NROWS * 1536 * 2, R_DT = R_YT + (size_t)NB * 512 * 4096 * 2, R_YF = R_DT + (size_t)NROWS * 16 * 4, R_YB = R_YF + (size_t)NB * SEQ * 512 * 2, R_END1 = R_YB + (size_t)NB * SEQ * 512 * 2;
constexpr size_t R_END0 = (size_t)NROWS * 2048 * 2, R_ENDF = R_PBND + (size_t)512 * DFF2 * 2;
constexpr size_t R_SIZE = (R_END1 > R_END0 ? (R_END1 > R_ENDF ? R_END1 : R_ENDF) : (R_END0 > R_ENDF ? R_END0 : R_ENDF));
constexpr size_t WS_BAR = WS_R + R_SIZE;
constexpr size_t WS_STATS = WS_BAR + 16384;
constexpr size_t WS_END = WS_STATS + (size_t)NROWS * 8;

struct Params { const float* in[30]; float* out; unsigned char* ws; int ph_lo, ph_hi; };

typedef __bf16 bf16x2_t __attribute__((ext_vector_type(2)));
__device__ __forceinline__ unsigned cvt_pk_bf16(float lo, float hi) { const f32x2 v = {lo, hi}; const bf16x2_t b = __builtin_convertvector(v, bf16x2_t); return __builtin_bit_cast(unsigned, b); }
__device__ __forceinline__ bf16_t f2bf(float f) { return (bf16_t)(cvt_pk_bf16(f, 0.f) & 0xffffu); }
__device__ __forceinline__ unsigned cvt_pk_bf16_asm(float lo, float hi) { unsigned r; asm volatile("v_cvt_pk_bf16_f32 %0, %1, %2" : "=v"(r) : "v"(lo), "v"(hi)); return r; }
__device__ __forceinline__ float bf2f(unsigned short b) { return __uint_as_float(((unsigned)b) << 16); }
__device__ __forceinline__ float bflo(unsigned w) { return __uint_as_float(w << 16); }
__device__ __forceinline__ float bfhi(unsigned w) { return __uint_as_float(w & 0xffff0000u); }
__device__ __forceinline__ float silu_f(float x) { return x * __builtin_amdgcn_rcpf(1.f + __expf(-x)); }
__device__ __forceinline__ float gelu_tanh(float x) { const float u = 0.7978845608028654f * (x + 0.044715f * x * x * x); const float e = __expf(-2.f * fabsf(u)); const float t = (1.f - e) * __builtin_amdgcn_rcpf(1.f + e); return 0.5f * x * (1.f + (u < 0.f ? -t : t)); }
__device__ __forceinline__ float softplus_f(float x) { return x > 20.f ? x : log1pf(__expf(x)); }
#define KSWZ(row, colB) ((row) * 256 + ((colB) ^ (((row) & 7) << 4)))
__device__ __forceinline__ void unpack8(const u32x4 w, float* f) { f[0] = bflo(w.x); f[1] = bfhi(w.x); f[2] = bflo(w.y); f[3] = bfhi(w.y); f[4] = bflo(w.z); f[5] = bfhi(w.z); f[6] = bflo(w.w); f[7] = bfhi(w.w); }
__device__ __forceinline__ u32x4 pack8(const float* f) { u32x4 w; w.x = cvt_pk_bf16(f[0], f[1]); w.y = cvt_pk_bf16(f[2], f[3]); w.z = cvt_pk_bf16(f[4], f[5]); w.w = cvt_pk_bf16(f[6], f[7]); return w; }

namespace pg8 {
constexpr int BM = 256, BK = 64, HALF = 128, HTB = HALF * BK * 2, STAGE_BYTES = 8 * HTB, NXCD = 8, WGM = 8;
__device__ __forceinline__ int lds_byte(int r, int c) { const int st = (r >> 4) * 2 + (c >> 5), rr = r & 15, cc = c & 31, ob = rr * 64 + cc * 2; return st * 1024 + (ob ^ (((ob >> 9) & 1) << 5)); }
__device__ __forceinline__ void stage_rc(int b, int& R, int& C) { const int st = b / 1024, sb = b % 1024, swz = sb ^ (((sb >> 9) & 1) << 5); R = (st >> 1) * 16 + swz / 64; C = (st & 1) * 32 + (swz % 64) / 2; }
__device__ __forceinline__ int perm32(int rho) { const int n = rho >> 4, i = rho & 15; return 8 * (i >> 2) + 4 * n + (i & 3); }

struct Unit { int pm, pn, orow, ocol, bat, s0, ni; };

enum { MAP_PLAIN = 0, MAP_LATENT = 1, MAP_DFT = 2, MAP_FSWAP = 3, MAP_RAW = 4 };
enum { EPI_BF16 = 0, EPI_BF16_DT = 1, EPI_RES = 2, EPI_UPF = 3 };
struct Desc {
    const bf16_t* A; const bf16_t* Bt; int K;
    int map, nM, nN, b0;
    int a_local;
    int o_local;
    int epi; int perm;
    void* O; int ldc;
    float* DT;
    const float* gate;
    const float* xin; const float* cin;
    const float* stats; const float* lng; const float* lnb;
    const float* cw; const float* cb; const bf16_t* pbnd;
};

__device__ __forceinline__ bool sched_next(const Desc& d, int i, int G, int c, Unit& u) {
    const int nM = d.nM, nN = d.nN, nwg = nM * nN;
    const long L = (long)i * G + c; if (L >= nwg) return false;
    int wgid = (int)L; { const int q = nwg / NXCD, r = nwg % NXCD, xcd = wgid % NXCD, off = wgid / NXCD; wgid = (xcd < r ? xcd * (q + 1) : r * (q + 1) + (xcd - r) * q) + off; }
    const int nig = WGM * nN, gid = wgid / nig, fm = gid * WGM, gsz = (nM - fm) < WGM ? (nM - fm) : WGM;
    const int mi = fm + ((wgid % nig) % gsz), ni = (wgid % nig) / gsz;
    u.ni = ni;
    if (d.map == MAP_PLAIN) {
        const int t = d.b0 * 9 + mi; u.bat = t / 9; u.s0 = (t % 9) * 256; u.pm = d.a_local ? mi : t; u.pn = ni; u.orow = (d.o_local ? mi : t) * 256; u.ocol = ni * 256;
    } else if (d.map == MAP_LATENT) {
        const int bl = mi >> 3, j = mi & 7, t = (d.b0 + bl) * 9 + 1 + j, tl = bl * 9 + 1 + j; u.bat = d.b0 + bl; u.s0 = 256 + j * 256; u.pm = d.a_local ? tl : t; u.pn = ni; u.orow = (d.o_local ? tl : t) * 256; u.ocol = ni * 256;
    } else if (d.map == MAP_DFT) {
        const int bl = mi >> 3, j = mi & 7; u.bat = bl; u.s0 = 256 + j * 256; u.pm = j; u.pn = bl * 2 + ni; u.orow = bl * SPB + 256 + j * 256; u.ocol = ni * 256;
    } else if (d.map == MAP_RAW) {
        u.bat = 0; u.s0 = 0; u.pm = mi; u.pn = ni; u.orow = mi * 256; u.ocol = ni * 256;
    } else {
        const int bl = ni >> 3, j = ni & 7; u.bat = bl; u.s0 = 0; u.pm = mi; u.pn = bl * 9 + 1 + j; u.orow = bl * 512 + (mi & 1) * 256; u.ocol = (mi >> 1) * 2048 + j * 256;
    }
    return true;
}

__device__ __forceinline__ void epilogue(const Desc& d, const f32x4 (&acc)[2][2][4][2], const Unit& u, int wr, int wc, int fr, int fq) {
    if (d.epi == EPI_RES) {
        bf16_t* XL = (bf16_t*)d.O;
        const int col0 = u.ocol + wc * 32 + 8 * fq;
        const float* gp = d.gate + (size_t)(u.s0 == 0 ? 32 : u.bat) * 6144 + col0;
        const float* fbase = nullptr; size_t brow0 = 0;
        if (d.xin) { if (u.s0 == 0) { fbase = d.cin; brow0 = (size_t)u.bat * CTXL; } else { fbase = d.xin; brow0 = (size_t)u.bat * SEQ + (u.s0 - 256); } }
#pragma unroll
        for (int bj = 0; bj < 2; ++bj) {
            const int co = bj * HALF;
            const f32x4 gv0 = *(const f32x4*)(gp + co), gv1 = *(const f32x4*)(gp + co + 4);
            f32x4 lg0 = {1.f, 1.f, 1.f, 1.f}, lg1 = lg0, lb0 = {0.f, 0.f, 0.f, 0.f}, lb1 = lb0;
            if (d.stats) { lg0 = *(const f32x4*)(d.lng + col0 + co); lg1 = *(const f32x4*)(d.lng + col0 + co + 4); lb0 = *(const f32x4*)(d.lnb + col0 + co); lb1 = *(const f32x4*)(d.lnb + col0 + co + 4); }
#define RES_FINISH(C0, C1, M_) do { f32x4 c0_ = (C0), c1_ = (C1); const int r_ = ai * HALF + wr * 64 + (M_) * 16 + fr; \
                    if (d.stats) { c0_ = (c0_ - st[M_][0]) * st[M_][1] * lg0 + lb0; c1_ = (c1_ - st[M_][0]) * st[M_][1] * lg1 + lb1; } \
                    const f32x4 o0_ = c0_ * DN_ALPHA + gv0 * acc[ai][bj][M_][0], o1_ = c1_ * DN_ALPHA + gv1 * acc[ai][bj][M_][1]; \
                    u32x4 w_; w_.x = cvt_pk_bf16(o0_[0], o0_[1]); w_.y = cvt_pk_bf16(o0_[2], o0_[3]); w_.z = cvt_pk_bf16(o1_[0], o1_[1]); w_.w = cvt_pk_bf16(o1_[2], o1_[3]); \
                    *(u32x4*)(XL + ((size_t)u.orow + r_) * 1024 + col0 + co) = w_; } while (0)
            if (fbase) {
#pragma unroll
                for (int ai = 0; ai < 2; ++ai) {
                    f32x4 b0[4], b1[4]; const f32x2 st[4] = {{0.f, 1.f}, {0.f, 1.f}, {0.f, 1.f}, {0.f, 1.f}};
#pragma unroll
                    for (int m = 0; m < 4; ++m) { const float* bp = fbase + (brow0 + ai * HALF + wr * 64 + m * 16 + fr) * 1024 + col0 + co; b0[m] = *(const f32x4*)(bp); b1[m] = *(const f32x4*)(bp + 4); }
#pragma unroll
                    for (int m = 0; m < 4; ++m) RES_FINISH(b0[m], b1[m], m);
                }
            } else {
#pragma unroll
                for (int ai = 0; ai < 2; ++ai) {
                    u32x4 bw[4]; f32x2 st[4];
#pragma unroll
                    for (int m = 0; m < 4; ++m) { const size_t rr = (size_t)u.orow + ai * HALF + wr * 64 + m * 16 + fr; bw[m] = *(const u32x4*)(XL + rr * 1024 + col0 + co); st[m] = d.stats ? *(const f32x2*)(d.stats + rr * 2) : (f32x2){0.f, 1.f}; }
#pragma unroll
                    for (int m = 0; m < 4; ++m) RES_FINISH(((f32x4){bflo(bw[m].x), bfhi(bw[m].x), bflo(bw[m].y), bfhi(bw[m].y)}), ((f32x4){bflo(bw[m].z), bfhi(bw[m].z), bflo(bw[m].w), bfhi(bw[m].w)}), m);
                }
            }
#undef RES_FINISH
        }
    } else {
        if (d.epi == EPI_BF16_DT && u.ni == 6) {
            if (wc == 0 && fq < 2) {
#pragma unroll
                for (int ai = 0; ai < 2; ++ai)
#pragma unroll
                    for (int m = 0; m < 4; ++m) { float* rowp = d.DT + ((size_t)u.orow + ai * HALF + wr * 64 + m * 16 + fr) * 16 + 8 * fq;
                        *(f32x4*)(rowp) = acc[ai][0][m][0]; *(f32x4*)(rowp + 4) = acc[ai][0][m][1]; }
            }
            return;
        }
        bf16_t* O = (bf16_t*)d.O; const int ldc = d.ldc;
        const int col0 = u.ocol + wc * 32 + 8 * fq;
#pragma unroll
        for (int ai = 0; ai < 2; ++ai)
#pragma unroll
            for (int m = 0; m < 4; ++m) { bf16_t* rowp = O + ((size_t)u.orow + ai * HALF + wr * 64 + m * 16 + fr) * ldc + col0;
#pragma unroll
                for (int bj = 0; bj < 2; ++bj) { const f32x4 v0 = acc[ai][bj][m][0], v1 = acc[ai][bj][m][1];
                    u32x4 w; w.x = cvt_pk_bf16(v0[0], v0[1]); w.y = cvt_pk_bf16(v0[2], v0[3]); w.z = cvt_pk_bf16(v1[0], v1[1]); w.w = cvt_pk_bf16(v1[2], v1[3]);
                    *(u32x4*)(rowp + bj * HALF) = w; } }
    }
}


__device__ __forceinline__ float dpp_shr1(float v) { return __int_as_float(__builtin_amdgcn_update_dpp(0, __float_as_int(v), 0x111, 0xf, 0xf, true)); }
__device__ __forceinline__ float dpp_shl1(float v) { return __int_as_float(__builtin_amdgcn_update_dpp(0, __float_as_int(v), 0x101, 0xf, 0xf, true)); }
__device__ __forceinline__ float dpp_mir(float v) { return __int_as_float(__builtin_amdgcn_update_dpp(0, __float_as_int(v), 0x140, 0xf, 0xf, true)); }
__device__ __forceinline__ void epilogue_upf(const Desc& d, const f32x4 (&acc)[2][2][4][2], const Unit& u, int wr, int wc, int fr, int fq, LAS unsigned char* lds) {
    LAS float* XB = (LAS float*)(lds + STAGE_BYTES);
    const int colb = 32 * wc + 8 * fq;
    f32x4 wa0[3], wg0[3], ba0, bg0;
    { const int j = u.ni * 128 + colb;
#pragma unroll
        for (int k = 0; k < 3; ++k) { wa0[k] = *(const f32x4*)(d.cw + k * DFF2 + j); wg0[k] = *(const f32x4*)(d.cw + k * DFF2 + DFF + j); }
        ba0 = *(const f32x4*)(d.cb + j); bg0 = *(const f32x4*)(d.cb + DFF + j); }
    const int jt = (u.s0 - 256) >> 8;
    const bool has_lo = u.s0 > 256, has_hi = (u.s0 >= 256) && (jt < 7);
    u32x2 hal[2][2] = {{{0u, 0u}, {0u, 0u}}, {{0u, 0u}, {0u, 0u}}};
    if (wr == 0 ? has_lo : has_hi) {
        const bf16_t* hp = d.pbnd + (size_t)(wr == 0 ? ((u.bat * 7 + jt - 1) * 2 + 0) : ((u.bat * 7 + jt) * 2 + 1)) * DFF2 + u.ocol + colb;
#pragma unroll
        for (int n = 0; n < 2; ++n) { hal[n][0] = *(const u32x2*)(hp + 4 * n); hal[n][1] = *(const u32x2*)(hp + 128 + 4 * n); }
    }
    if (fr == 0) {
#pragma unroll
        for (int ai = 0; ai < 2; ++ai)
#pragma unroll
            for (int bj = 0; bj < 2; ++bj)
#pragma unroll
                for (int n = 0; n < 2; ++n) *(LAS f32x4*)(XB + ((2 * ai + wr) * 2 + 0) * 256 + 128 * bj + colb + 4 * n) = acc[ai][bj][0][n];
    }
    if (fr == 15) {
#pragma unroll
        for (int ai = 0; ai < 2; ++ai)
#pragma unroll
            for (int bj = 0; bj < 2; ++bj)
#pragma unroll
                for (int n = 0; n < 2; ++n) *(LAS f32x4*)(XB + ((2 * ai + wr) * 2 + 1) * 256 + 128 * bj + colb + 4 * n) = acc[ai][bj][3][n];
    }
    asm volatile("s_waitcnt lgkmcnt(0)" ::: "memory"); __builtin_amdgcn_s_barrier(); asm volatile("" ::: "memory"); __builtin_amdgcn_s_barrier(); asm volatile("" ::: "memory");
    const float m0 = (fr == 0) ? 1.f : 0.f, m15 = (fr == 15) ? 1.f : 0.f;
    bf16_t* G = (bf16_t*)d.O;
#pragma unroll
    for (int n = 0; n < 2; ++n) {
        const int j = u.ni * 128 + colb + 4 * n;
        f32x4 wa[3], wg[3], ba, bg;
        if (n == 0) {
#pragma unroll
            for (int k = 0; k < 3; ++k) { wa[k] = wa0[k]; wg[k] = wg0[k]; }
            ba = ba0; bg = bg0;
        } else {
#pragma unroll
            for (int k = 0; k < 3; ++k) { wa[k] = *(const f32x4*)(d.cw + k * DFF2 + j); wg[k] = *(const f32x4*)(d.cw + k * DFF2 + DFF + j); }
            ba = *(const f32x4*)(d.cb + j); bg = *(const f32x4*)(d.cb + DFF + j);
        }
#pragma unroll
        for (int ai = 0; ai < 2; ++ai) {
            const int q = 2 * ai + wr;
            f32x4 pra, prg, sua, sug;
            if (q > 0) { pra = *(const LAS f32x4*)(XB + ((q - 1) * 2 + 1) * 256 + colb + 4 * n); prg = *(const LAS f32x4*)(XB + ((q - 1) * 2 + 1) * 256 + 128 + colb + 4 * n); }
            else { const u32x2 a_ = hal[n][0], g_ = hal[n][1]; pra = (f32x4){bflo(a_.x), bfhi(a_.x), bflo(a_.y), bfhi(a_.y)}; prg = (f32x4){bflo(g_.x), bfhi(g_.x), bflo(g_.y), bfhi(g_.y)}; }
            if (q < 3) { sua = *(const LAS f32x4*)(XB + ((q + 1) * 2 + 0) * 256 + colb + 4 * n); sug = *(const LAS f32x4*)(XB + ((q + 1) * 2 + 0) * 256 + 128 + colb + 4 * n); }
            else { const u32x2 a_ = hal[n][0], g_ = hal[n][1]; sua = (f32x4){bflo(a_.x), bfhi(a_.x), bflo(a_.y), bfhi(a_.y)}; sug = (f32x4){bflo(g_.x), bfhi(g_.x), bflo(g_.y), bfhi(g_.y)}; }
#pragma unroll
            for (int m = 0; m < 4; ++m) {
                const f32x4 va = acc[ai][0][m][n], vg = acc[ai][1][m][n];
                float o[4];
#pragma unroll
                for (int e = 0; e < 4; ++e) {
                    const float ea = (m > 0) ? dpp_mir(acc[ai][0][m > 0 ? m - 1 : 0][n][e]) : pra[e], eg = (m > 0) ? dpp_mir(acc[ai][1][m > 0 ? m - 1 : 0][n][e]) : prg[e];
                    const float fa = (m < 3) ? dpp_mir(acc[ai][0][m < 3 ? m + 1 : 3][n][e]) : sua[e], fg = (m < 3) ? dpp_mir(acc[ai][1][m < 3 ? m + 1 : 3][n][e]) : sug[e];
                    const float pa = fmaf(m0, ea, dpp_shr1(va[e])), pg = fmaf(m0, eg, dpp_shr1(vg[e]));
                    const float na = fmaf(m15, fa, dpp_shl1(va[e])), ng = fmaf(m15, fg, dpp_shl1(vg[e]));
                    const float a = ba[e] + wa[0][e] * pa + wa[1][e] * va[e] + wa[2][e] * na;
                    const float g = bg[e] + wg[0][e] * pg + wg[1][e] * vg[e] + wg[2][e] * ng;
                    o[e] = a * silu_f(g);
                }
                u32x2 w; w.x = cvt_pk_bf16(o[0], o[1]); w.y = cvt_pk_bf16(o[2], o[3]);
                *(u32x2*)(G + ((size_t)u.orow + ai * HALF + wr * 64 + m * 16 + fr) * DFF + j) = w;
                __builtin_amdgcn_sched_barrier(0);
            }
        }
    }
}

__device__ __forceinline__ void gemm_phase(LAS unsigned char* lds, const Desc& g, int G, int cidx, const int tid) {
    const int wid = __builtin_amdgcn_readfirstlane(tid >> 6), lane = tid & 63, wr = wid >> 2, wc = wid & 3, fr = lane & 15, fq = lane >> 4;
    const int K = g.K, nt = K / BK;
    unsigned voffA[2], voffB[2];
#pragma unroll
    for (int i = 0; i < 2; ++i) { int R, C; stage_rc(tid * 16 + i * 8192, R, C); const int Rb = g.perm ? ((R & ~31) + perm32(R & 31)) : R;
        voffA[i] = (unsigned)(R * K + C) * 2u; voffB[i] = (unsigned)(Rb * K + C) * 2u; }
    const size_t kstep = (size_t)(BK * 2);
    const size_t hstep = (size_t)HALF * K * 2;
    const size_t tstep = 2 * hstep;
    const unsigned ldsw = (unsigned)wid * 1024u;
    const int aoff = lds_byte(wr * 64 + fr, fq * 8), boff = lds_byte(wc * 32 + fr, fq * 8);
#define PG8_SA(b, h) (((b) * 2 + (h)) * HTB)
#define PG8_SB(b, h) ((4 + (b) * 2 + (h)) * HTB)
#define PG8_STAGE(bufoff, gbase, voff) do { _Pragma("unroll") for (int _i = 0; _i < 2; ++_i) \
        __builtin_amdgcn_global_load_lds((const unsigned*)((const char*)(gbase) + (voff)[_i]), (LAS unsigned*)(lds + (bufoff) + ldsw + _i * 8192), 16, 0, 0); } while (0)
#define PG8_LDA(dst, b, h) do { _Pragma("unroll") for (int m = 0; m < 4; ++m) _Pragma("unroll") for (int k = 0; k < 2; ++k) dst[m][k] = *(const LAS bf16x8*)(lds + PG8_SA(b, h) + aoff + m * 2048 + k * 1024); } while (0)
#define PG8_LDB(dst, b, h) do { _Pragma("unroll") for (int n = 0; n < 2; ++n) _Pragma("unroll") for (int k = 0; k < 2; ++k) dst[n][k] = *(const LAS bf16x8*)(lds + PG8_SB(b, h) + boff + n * 2048 + k * 1024); } while (0)
#define PG8_MMA(ai, bj, At, Bt) do { __builtin_amdgcn_s_setprio(1); _Pragma("unroll") for (int m = 0; m < 4; ++m) _Pragma("unroll") for (int n = 0; n < 2; ++n) _Pragma("unroll") for (int k = 0; k < 2; ++k) \
        acc[ai][bj][m][n] = __builtin_amdgcn_mfma_f32_16x16x32_bf16(Bt[n][k], At[m][k], acc[ai][bj][m][n], 0, 0, 0); __builtin_amdgcn_s_setprio(0); } while (0)
#define PG8_WAIT_V(n) asm volatile("s_waitcnt vmcnt(" #n ")" ::: "memory")
#define PG8_WAIT_L(n) asm volatile("s_waitcnt lgkmcnt(" #n ")" ::: "memory")
#define PG8_BAR __builtin_amdgcn_s_barrier()
#define PG8_SCHED __builtin_amdgcn_sched_barrier(0)
    Unit cur, nxt; int ui = 0;
    if (!sched_next(g, 0, G, cidx, cur)) return;
    f32x4 acc[2][2][4][2];
#pragma unroll
    for (int a = 0; a < 2; ++a)
#pragma unroll
        for (int b = 0; b < 2; ++b)
#pragma unroll
            for (int m = 0; m < 4; ++m)
#pragma unroll
                for (int n = 0; n < 2; ++n) acc[a][b][m][n] = (f32x4){0.f, 0.f, 0.f, 0.f};
    bf16x8 At[4][2], B0[2][2], B1[2][2];
    const char* cA = (const char*)g.A + (size_t)cur.pm * tstep; const char* cB = (const char*)g.Bt + (size_t)cur.pn * tstep;
    PG8_STAGE(PG8_SB(0, 0), cB, voffB); PG8_STAGE(PG8_SB(0, 1), cB + hstep, voffB); PG8_STAGE(PG8_SA(0, 0), cA, voffA); PG8_STAGE(PG8_SA(0, 1), cA + hstep, voffA);
    if (wr == 1) PG8_BAR;
    PG8_WAIT_V(2); PG8_BAR;
    PG8_STAGE(PG8_SB(1, 0), cB + kstep, voffB); PG8_STAGE(PG8_SA(1, 0), cA + kstep, voffA); PG8_STAGE(PG8_SB(1, 1), cB + hstep + kstep, voffB);
    PG8_WAIT_V(6); PG8_BAR;
    for (;;) {
        const bool has_next = sched_next(g, ui + 1, G, cidx, nxt);
        const char* nA = has_next ? (const char*)g.A + (size_t)nxt.pm * tstep : cA; const char* nB = has_next ? (const char*)g.Bt + (size_t)nxt.pn * tstep : cB;
        for (int t = 0; t < nt; t += 2) {
            const bool last = (t == nt - 2);
            const char* a1 = cA + (size_t)(t + 1) * kstep;
            const char* a2 = last ? nA : cA + (size_t)(t + 2) * kstep; const char* b2 = last ? nB : cB + (size_t)(t + 2) * kstep;
            const char* a3 = a2 + kstep; const char* b3 = b2 + kstep;
            PG8_LDB(B0, 0, 0); PG8_LDB(B1, 0, 1); PG8_SCHED; PG8_LDA(At, 0, 0); PG8_STAGE(PG8_SA(1, 1), a1 + hstep, voffA);
            PG8_WAIT_V(8); PG8_WAIT_L(0); PG8_BAR; PG8_MMA(0, 0, At, B0); PG8_MMA(0, 1, At, B1); PG8_BAR; PG8_SCHED;
            PG8_LDA(At, 0, 1); PG8_STAGE(PG8_SB(0, 0), b2, voffB); PG8_STAGE(PG8_SB(0, 1), b2 + hstep, voffB); PG8_STAGE(PG8_SA(0, 0), a2, voffA);
            PG8_WAIT_V(8); PG8_WAIT_L(0); PG8_BAR; PG8_MMA(1, 0, At, B0); PG8_MMA(1, 1, At, B1); PG8_BAR; PG8_SCHED;
            PG8_LDB(B0, 1, 0); PG8_LDB(B1, 1, 1); PG8_SCHED; PG8_LDA(At, 1, 0); PG8_STAGE(PG8_SA(0, 1), a2 + hstep, voffA);
            PG8_WAIT_V(8); PG8_WAIT_L(0); PG8_BAR; PG8_MMA(0, 0, At, B0); PG8_MMA(0, 1, At, B1); PG8_BAR; PG8_SCHED;
            PG8_LDA(At, 1, 1); PG8_STAGE(PG8_SB(1, 0), b3, voffB); PG8_STAGE(PG8_SB(1, 1), b3 + hstep, voffB); PG8_STAGE(PG8_SA(1, 0), a3, voffA);
            PG8_WAIT_V(8); PG8_WAIT_L(0); PG8_BAR; PG8_MMA(1, 0, At, B0); PG8_MMA(1, 1, At, B1); PG8_BAR; PG8_SCHED;
        }
        if (wr == 0) PG8_BAR;
        { int lane2 = lane; asm volatile("" : "+v"(lane2)); if (g.epi == EPI_UPF) epilogue_upf(g, acc, cur, wr, wc, lane2 & 15, lane2 >> 4, lds); else epilogue(g, acc, cur, wr, wc, lane2 & 15, lane2 >> 4); }
        if (!has_next) break;
#pragma unroll
        for (int a = 0; a < 2; ++a)
#pragma unroll
            for (int b = 0; b < 2; ++b)
#pragma unroll
                for (int m = 0; m < 4; ++m)
#pragma unroll
                    for (int n = 0; n < 2; ++n) acc[a][b][m][n] = (f32x4){0.f, 0.f, 0.f, 0.f};
        cur = nxt; cA = nA; cB = nB; ++ui;
        if (wr == 1) PG8_BAR;
    }
    PG8_WAIT_V(0);
    PG8_BAR;
#undef PG8_SA
#undef PG8_SB
#undef PG8_STAGE
#undef PG8_LDA
#undef PG8_LDB
#undef PG8_MMA
#undef PG8_WAIT_V
#undef PG8_WAIT_L
#undef PG8_BAR
#undef PG8_SCHED
}
}

namespace att {
constexpr int D = 128, NW = 8, QBLK = 32, KVBLK = 64;
constexpr float SCALE = 0.088388347648318440f;
constexpr float THR = 8.f;
constexpr int LDQ = 2048, LDK = 2048, LDO = 1024;
constexpr size_t SHM_V = KVBLK * D * 2, SHM_K = KVBLK * D * 2, SHM_ATTN = 2 * SHM_V + 2 * SHM_K + NW * 64 * 4;
#define SBAR() __builtin_amdgcn_sched_barrier(0)
__device__ __forceinline__ int crow(int r, int hi) { return (r & 3) + 8 * (r >> 2) + 4 * hi; }
__device__ __forceinline__ void partialSM(f32x16& p0, f32x16& p1, float& m_reg, float& mn, float& alpha) {
  constexpr float C = SCALE * 1.4426950408889634f;
  float pmax = p0[0]; for (int r = 1; r < 16; ++r) pmax = fmaxf(pmax, p0[r]); for (int r = 0; r < 16; ++r) pmax = fmaxf(pmax, p1[r]);
  { auto rr = __builtin_amdgcn_permlane32_swap(__float_as_uint(pmax), __float_as_uint(pmax), false, false);
    pmax = fmaxf(__uint_as_float(rr[0]), __uint_as_float(rr[1])); }
  if (__builtin_expect(__all(pmax - m_reg <= THR / SCALE), 1)) { mn = m_reg; alpha = 1.f; }
  else { mn = fmaxf(m_reg, pmax); alpha = __builtin_amdgcn_exp2f((m_reg - mn) * C); m_reg = mn; }
  float mnC = -mn * C;
  for (int r = 0; r < 16; ++r) p0[r] = fmaf(p0[r], C, mnC); for (int r = 0; r < 16; ++r) p1[r] = fmaf(p1[r], C, mnC);
  for (int r = 0; r < 16; ++r) p0[r] = __builtin_amdgcn_exp2f(p0[r]);
}
__device__ __forceinline__ void finishSM(f32x16& p0, f32x16& p1, float alpha, float& l_reg, bf16x8& pa0, bf16x8& pa1, bf16x8& pa2, bf16x8& pa3) {
  for (int r = 0; r < 16; ++r) p1[r] = __builtin_amdgcn_exp2f(p1[r]);
  float ps = 0; for (int r = 0; r < 16; ++r) ps += p0[r]; for (int r = 0; r < 16; ++r) ps += p1[r];
  { auto rr = __builtin_amdgcn_permlane32_swap(__float_as_uint(ps), __float_as_uint(ps), false, false);
    ps = __uint_as_float(rr[0]) + __uint_as_float(rr[1]); }
  l_reg = l_reg * alpha + ps;
#define PK4(P, BASE, OUT) do { unsigned a0 = cvt_pk_bf16_asm(P[BASE + 0], P[BASE + 1]), a1 = cvt_pk_bf16_asm(P[BASE + 2], P[BASE + 3]);   \
    unsigned b0 = cvt_pk_bf16_asm(P[BASE + 4], P[BASE + 5]), b1 = cvt_pk_bf16_asm(P[BASE + 6], P[BASE + 7]);                              \
    auto r0 = __builtin_amdgcn_permlane32_swap(a0, b0, false, false); auto r1 = __builtin_amdgcn_permlane32_swap(a1, b1, false, false); \
    u32x4 w = {r0[0], r1[0], r0[1], r1[1]}; OUT = *reinterpret_cast<bf16x8*>(&w); } while (0)
  PK4(p0, 0, pa0); PK4(p0, 8, pa1); PK4(p1, 0, pa2); PK4(p1, 8, pa3);
#undef PK4
}
__device__ __forceinline__ void qkt(f32x16& p0, f32x16& p1, const bf16_t* Ks, const bf16x8* qr, int r32, int hi) {
  p0 = f32x16{}; p1 = f32x16{};
  for (int d0 = 0; d0 < 8; ++d0) { int cb = (d0 * 16 + hi * 8) * 2;
    bf16x8 b0 = *reinterpret_cast<const bf16x8*>((const char*)Ks + KSWZ(r32, cb));
    bf16x8 b1 = *reinterpret_cast<const bf16x8*>((const char*)Ks + KSWZ(32 + r32, cb));
    p0 = __builtin_amdgcn_mfma_f32_32x32x16_bf16(b0, qr[d0], p0, 0, 0, 0);
    p1 = __builtin_amdgcn_mfma_f32_32x32x16_bf16(b1, qr[d0], p1, 0, 0, 0); }
}
__device__ __forceinline__ int v_st(int k, int c) { const int kk = (k & ~0xC) | ((k & 4) << 1) | ((k & 8) >> 1); return ((kk >> 3) * 4 + (c >> 5)) * 512 + ((kk & 7) * 32 + (c & 31)) * 2; }
__device__ __forceinline__ int v_rd_base(int lane) { return ((lane & 3) << 3) | (((lane >> 2) & 3) << 6) | (((lane >> 4) & 1) << 5) | (((lane >> 5) & 1) << 8); }
constexpr int v_rd_off(int d0, int ks, int half) { return d0 * 512 + ks * 4096 + half * 2048; }
template <int OFF> __device__ __forceinline__ s16x4 tr_read(int vb) {
  s16x4 r; asm volatile("ds_read_b64_tr_b16 %0, %1 offset:%2" : "=&v"(r) : "v"(vb), "i"(OFF) : "memory"); return r;
}
template <int D0> __device__ __forceinline__ void pv_one(f32x16& od, int vb, bf16x8 pa0, bf16x8 pa1, bf16x8 pa2, bf16x8 pa3) {
  const s16x4 l0 = tr_read<v_rd_off(D0, 0, 0)>(vb), h0 = tr_read<v_rd_off(D0, 0, 1)>(vb), l1 = tr_read<v_rd_off(D0, 1, 0)>(vb), h1 = tr_read<v_rd_off(D0, 1, 1)>(vb);
  const s16x4 l2 = tr_read<v_rd_off(D0, 2, 0)>(vb), h2 = tr_read<v_rd_off(D0, 2, 1)>(vb), l3 = tr_read<v_rd_off(D0, 3, 0)>(vb), h3 = tr_read<v_rd_off(D0, 3, 1)>(vb);
  asm volatile("s_waitcnt lgkmcnt(0)" ::: "memory"); SBAR();
#define PK(L, H) (bf16x8){L[0], L[1], L[2], L[3], H[0], H[1], H[2], H[3]}
  od = __builtin_amdgcn_mfma_f32_32x32x16_bf16(pa0, PK(l0, h0), od, 0, 0, 0);
  od = __builtin_amdgcn_mfma_f32_32x32x16_bf16(pa1, PK(l1, h1), od, 0, 0, 0);
  od = __builtin_amdgcn_mfma_f32_32x32x16_bf16(pa2, PK(l2, h2), od, 0, 0, 0);
  od = __builtin_amdgcn_mfma_f32_32x32x16_bf16(pa3, PK(l3, h3), od, 0, 0, 0);
#undef PK
}
__device__ __forceinline__ void pv_d0(f32x16* o, int vb, bf16x8 pa0, bf16x8 pa1, bf16x8 pa2, bf16x8 pa3) {
  pv_one<0>(o[0], vb, pa0, pa1, pa2, pa3); pv_one<1>(o[1], vb, pa0, pa1, pa2, pa3); pv_one<2>(o[2], vb, pa0, pa1, pa2, pa3); pv_one<3>(o[3], vb, pa0, pa1, pa2, pa3);
}
__device__ __forceinline__ void attn_dense_body(const bf16_t* __restrict__ Qb, const bf16_t* __restrict__ Kh, const bf16_t* __restrict__ Vh, bf16_t* __restrict__ Ob, int seq, char* lds, const int tid) {
  const int wid = tid >> 6, lane = tid & 63, r32 = lane & 31, hi = lane >> 5;
  bf16_t* V_lds = (bf16_t*)lds; bf16_t* K_lds = (bf16_t*)(lds + 2 * SHM_V);
  float* ws = (float*)(lds + 2 * SHM_V + 2 * SHM_K) + wid * 64; float* li_l = ws; float* al_l = ws + 32;
  float m_reg = -1e30f, l_reg = 0; f32x16 o[4] = {}; bf16x8 qr[8];
  const bf16_t* Qw = Qb + (long)(wid * QBLK + r32) * LDQ + hi * 8;
#pragma unroll
  for (int d0 = 0; d0 < 8; ++d0) qr[d0] = *reinterpret_cast<const bf16x8*>(Qw + d0 * 16);
  const int sr = tid >> 4, sc = (tid & 15) * 8, vst0 = v_st(sr, sc), vst1 = v_st(32 + sr, sc);
  const int vb0 = (int)(uintptr_t)V_lds + v_rd_base(lane);
  struct { bf16x8 vs0, vs1, ks0, ks1; } sr_[2];
  const unsigned go0 = (unsigned)(sr * LDK + sc) * 2u, go1 = go0 + 32u * LDK * 2u;
#define SLOAD(i, k0) do { const char* vb_ = (const char*)Vh + (size_t)(k0) * (LDK * 2); const char* kb_ = (const char*)Kh + (size_t)(k0) * (LDK * 2); \
    sr_[i].vs0 = *reinterpret_cast<const bf16x8*>(vb_ + go0); sr_[i].vs1 = *reinterpret_cast<const bf16x8*>(vb_ + go1); \
    sr_[i].ks0 = *reinterpret_cast<const bf16x8*>(kb_ + go0); sr_[i].ks1 = *reinterpret_cast<const bf16x8*>(kb_ + go1); } while (0)
#define SWRITE(b, i) do { *(bf16x8*)((char*)V_lds + (b) * SHM_V + vst0) = sr_[i].vs0;          \
    *(bf16x8*)((char*)V_lds + (b) * SHM_V + vst1) = sr_[i].vs1; int kc = sc * 2;               \
    *(bf16x8*)((char*)K_lds + (b) * SHM_K + KSWZ(sr, kc)) = sr_[i].ks0;                       \
    *(bf16x8*)((char*)K_lds + (b) * SHM_K + KSWZ(32 + sr, kc)) = sr_[i].ks1; } while (0)
#define SWAIT() asm volatile("s_waitcnt vmcnt(4)" ::: "memory")
#define RESC(a) do { if (__any((a) < 1.f)) { if (hi == 0) al_l[r32] = (a); asm volatile("s_waitcnt lgkmcnt(0)" ::: "memory"); \
    for (int d = 0; d < 4; ++d) for (int r = 0; r < 16; ++r) o[d][r] *= al_l[crow(r, hi)]; } } while (0)
  f32x16 pA0, pA1, pB0, pB1; float mnA, mnB, alA, alB; bf16x8 pa0, pa1, pa2, pa3; const int NTL = seq / KVBLK;
  constexpr int SE = 0, SO = 1;
  SLOAD(SE, 0); asm volatile("s_waitcnt vmcnt(0)" ::: "memory"); SWRITE(0, SE); __syncthreads();
  qkt(pA0, pA1, K_lds, qr, r32, hi); partialSM(pA0, pA1, m_reg, mnA, alA);
  SLOAD(SO, KVBLK); if (2 < NTL) SLOAD(SE, 2 * KVBLK);
  SWAIT(); SWRITE(1, SO); __syncthreads();
  for (int j = 1; j + 1 < NTL; j += 2) {
    SBAR(); qkt(pB0, pB1, (bf16_t*)((char*)K_lds + SHM_K), qr, r32, hi);
    finishSM(pA0, pA1, alA, l_reg, pa0, pa1, pa2, pa3); SBAR();
    SLOAD(SO, (j + 2) * KVBLK); SBAR();
    pv_d0(o, vb0, pa0, pa1, pa2, pa3); partialSM(pB0, pB1, m_reg, mnB, alB);
    __syncthreads(); SWAIT(); SWRITE(0, SE);
    RESC(alB); __syncthreads();
    SBAR(); qkt(pA0, pA1, K_lds, qr, r32, hi);
    finishSM(pB0, pB1, alB, l_reg, pa0, pa1, pa2, pa3); SBAR();
    if (j + 3 < NTL) SLOAD(SE, (j + 3) * KVBLK); SBAR();
    pv_d0(o, vb0 + (int)SHM_V, pa0, pa1, pa2, pa3); partialSM(pA0, pA1, m_reg, mnA, alA);
    __syncthreads(); SWAIT(); SWRITE(1, SO);
    RESC(alA); __syncthreads();
  }
  SBAR(); qkt(pB0, pB1, (bf16_t*)((char*)K_lds + SHM_K), qr, r32, hi);
  finishSM(pA0, pA1, alA, l_reg, pa0, pa1, pa2, pa3); SBAR();
  pv_d0(o, vb0, pa0, pa1, pa2, pa3); partialSM(pB0, pB1, m_reg, mnB, alB);
  __syncthreads(); RESC(alB);
  finishSM(pB0, pB1, alB, l_reg, pa0, pa1, pa2, pa3); SBAR();
  pv_d0(o, vb0 + (int)SHM_V, pa0, pa1, pa2, pa3);
  if (hi == 0) li_l[r32] = l_reg; asm volatile("s_waitcnt lgkmcnt(0)" ::: "memory");
  int lane2 = lane; asm volatile("" : "+v"(lane2)); const int r32e = lane2 & 31, hie = lane2 >> 5;
  float rli[16];
#pragma unroll
  for (int r = 0; r < 16; ++r) rli[r] = __builtin_amdgcn_rcpf(li_l[crow(r, hie)]);
  bf16_t* Ow = Ob + (long)(wid * QBLK) * LDO + r32e;
#pragma unroll
  for (int r = 0; r < 16; ++r) { int orow = crow(r, hie);
#pragma unroll
    for (int d0 = 0; d0 < 4; ++d0) Ow[orow * LDO + d0 * 32] = (bf16_t)(cvt_pk_bf16_asm(o[d0][r] * rli[r], 0.f) & 0xffffu); }
#undef SLOAD
#undef SWRITE
#undef SWAIT
#undef RESC
}
}

struct Frame {
    const float* const* in; float* out; unsigned char* ws; unsigned char* lds; int tid, lane, wid, G, bx, wid0;
};
#define WSP(T, off) ((T*)(F.ws + (off)))
__device__ __forceinline__ void frame_refresh(Frame& F, const float* const* inb, unsigned char* wsb, float* outb, unsigned char* ldsb) {
    unsigned zero; asm volatile("s_mov_b32 %0, 0" : "=s"(zero));
    int lane_; asm volatile("v_mbcnt_lo_u32_b32 %0, -1, 0\n\tv_mbcnt_hi_u32_b32 %0, -1, %0" : "=v"(lane_));
    const int tid = (int)((unsigned)F.wid0 + zero) * 64 + lane_;
    F.in = inb + zero; F.ws = wsb + zero; F.out = outb + zero; F.lds = ldsb; F.bx = (int)(blockIdx.x + zero); F.G = (int)(gridDim.x + zero); F.tid = tid; F.lane = tid & 63; F.wid = __builtin_amdgcn_readfirstlane(tid >> 6);
}

__device__ __forceinline__ void cvt_tile(const Frame& F, const float* src, int ldw, int n0, int nvalid, int K, bf16_t* dst, int tn, int tk, int srccol) {
    float* T = (float*)F.lds;
    __syncthreads();
#pragma unroll
    for (int i = 0; i < 8; ++i) { const int kk = (F.tid >> 6) + 8 * i, nn = F.tid & 63; const int n = tn * 64 + nn;
        T[kk * 65 + nn] = (n < nvalid) ? src[(size_t)(tk * 64 + kk) * ldw + (srccol >= 0 ? srccol + nn : n0 + n)] : 0.f; }
    __syncthreads();
    const int nn = F.tid >> 3, ks = (F.tid & 7) * 8; float v[8];
#pragma unroll
    for (int e = 0; e < 8; ++e) v[e] = T[(ks + e) * 65 + nn];
    *(u32x4*)(dst + (size_t)(tn * 64 + nn) * K + tk * 64 + ks) = pack8(v);
}
__device__ __forceinline__ void phase_prep(const Frame& F) {
    {
        const int cnt[8] = {512, 256, 1408, 1408, 704, 704, 448, 256};
        int total = 0;
#pragma unroll
        for (int j = 0; j < 8; ++j) total += cnt[j];
        for (int t = F.bx; t < total; t += F.G) {
            int j = 0, loc = t;
#pragma unroll
            for (int q = 0; q < 8; ++q) { if (j == q && loc >= cnt[q]) { loc -= cnt[q]; j = q + 1; } }
            const float* src; int ldw, n0, nvalid, K; size_t dsto;
            switch (j) {
                case 0: src = F.in[14]; ldw = 2048; n0 = 0; nvalid = 2048; K = 1024; dsto = WS_W0IN; break;
                case 1: src = F.in[15]; ldw = 1024; n0 = 0; nvalid = 1024; K = 1024; dsto = WS_W0OUT; break;
                case 2: src = F.in[10]; ldw = DFF2; n0 = 0; nvalid = DFF2; K = 1024; dsto = WS_WUP0; break;
                case 3: src = F.in[10] + (size_t)1024 * DFF2; ldw = DFF2; n0 = 0; nvalid = DFF2; K = 1024; dsto = WS_WUP1; break;
                case 4: src = F.in[13]; ldw = 1024; n0 = 0; nvalid = 1024; K = DFF; dsto = WS_WDN0; break;
                case 5: src = F.in[13] + (size_t)DFF * 1024; ldw = 1024; n0 = 0; nvalid = 1024; K = DFF; dsto = WS_WDN1; break;
                case 6: src = F.in[22]; ldw = 2064; n0 = 512; nvalid = 1552; K = 1024; dsto = WS_W1IN; break;
                default: src = F.in[23]; ldw = 1024; n0 = 0; nvalid = 1024; K = 1024; dsto = WS_W1OUT; break;
            }
            const int nk = K / 64; const int tn = loc / nk, tk = loc % nk;
            const int srccol = (j == 2 || j == 3) ? (((tn >> 1) & 1) * DFF + (tn >> 2) * 128 + (tn & 1) * 64) : -1;
            cvt_tile(F, src, ldw, n0, nvalid, K, WSP(bf16_t, dsto), tn, tk, srccol);
        }
    }
    {
        float* Wt = (float*)F.lds;
        float* ctab = Wt + 64 * 129;
        bf16_t* W1F = WSP(bf16_t, WS_W1F);
        for (int job = F.bx; job < 64; job += F.G) {
            const int g = job >> 4, kt = job & 15;
            __syncthreads();
            if (F.tid < 128) ctab[F.tid] = cospif((float)F.tid / 64.f);
            for (int i = F.tid; i < 64 * 128; i += NT) { const int kk = i >> 7, d = i & 127; Wt[kk * 129 + d] = F.in[22][(size_t)(kt * 64 + kk) * 2064 + g * 128 + d]; }
            __syncthreads();
            const int o = F.tid >> 1, kh = (F.tid & 1) * 32;
            const int half = o >> 7, dp = o & 127;
            float accv[32];
#pragma unroll
            for (int e = 0; e < 32; ++e) accv[e] = 0.f;
            for (int d = 0; d < 128; ++d) {
                const int m = (d * dp) & 127; const float cs = ctab[half ? ((m - 32) & 127) : m];
#pragma unroll
                for (int e = 0; e < 32; ++e) accv[e] += cs * Wt[(kh + e) * 129 + d];
            }
            bf16_t* dst = W1F + (size_t)(half * 512 + g * 128 + dp) * 1024 + kt * 64 + kh;
#pragma unroll
            for (int e = 0; e < 32; e += 8) *(u32x4*)(dst + e) = pack8(accv + e);
        }
        __syncthreads();
    }
    {
        bf16_t* Dm = WSP(bf16_t, WS_DFT);
        for (size_t i = (size_t)F.bx * NT + F.tid; i < (size_t)2048 * 512; i += (size_t)F.G * NT) {
            const int lp = (int)(i >> 9), c8 = (int)(i & 511) * 8; float v[8];
#pragma unroll
            for (int e = 0; e < 8; ++e) { const int cidx = c8 + e; const int l = cidx & 2047; const int m = (l * lp) & 2047; const float a = (float)m / 1024.f;
                v[e] = (cidx < 2048 ? cospif(a) : -sinpif(a)) * (1.f / 512.f); }
            *(u32x4*)(Dm + (size_t)lp * 4096 + c8) = pack8(v);
        }
    }
    {
        f32x2* Rt = WSP(f32x2, WS_ROPE);
        for (int i = F.bx * NT + F.tid; i < 64 * 32; i += F.G * NT) { const int pos = i >> 5, f = i & 31; const float inv = expf(-(float)f * (9.210340371976184f / 32.f)); float sn, cs; sincosf((float)pos * inv, &sn, &cs); Rt[i] = (f32x2){cs, sn}; }
    }
    {
        bf16_t* Gw = WSP(bf16_t, WS_GWS);
        for (int i = F.bx * NT + F.tid; i < 65536 / 8; i += F.G * NT) { float v[8];
#pragma unroll
            for (int e = 0; e < 8; ++e) v[e] = F.in[18][i * 8 + e];
            *(u32x4*)(Gw + i * 8) = pack8(v); }
    }
    {
        float* cs = (float*)F.lds;
        float* red = cs + 33 * 256;
        float* MODP = WSP(float, WS_MODP);
        for (int job = F.bx; job < 384; job += F.G) {
            const int kq = job & 3, ntile = (job >> 2) % 48, layer = job / 192;
            __syncthreads();
            for (int i = F.tid; i < 33 * 256; i += NT) { const int j = i >> 8, kk = i & 255; const float cv = (j < 32) ? F.in[1][j * 1024 + kq * 256 + kk] : F.in[3][kq * 256 + kk]; cs[i] = silu_f(cv); }
            __syncthreads();
            const int nn = F.tid & 127, ks = F.tid >> 7;
            float a[33];
#pragma unroll
            for (int j = 0; j < 33; ++j) a[j] = 0.f;
            const float* wp = F.in[4] + ((size_t)layer * 1024 + kq * 256 + ks * 64) * 6144 + ntile * 128 + nn;
            for (int kk = 0; kk < 64; kk += 4) {
                const float w0 = wp[(size_t)(kk + 0) * 6144], w1 = wp[(size_t)(kk + 1) * 6144], w2 = wp[(size_t)(kk + 2) * 6144], w3 = wp[(size_t)(kk + 3) * 6144];
#pragma unroll
                for (int j = 0; j < 33; ++j) { const f32x4 c4 = *(const f32x4*)(cs + j * 256 + ks * 64 + kk); a[j] += w0 * c4[0] + w1 * c4[1] + w2 * c4[2] + w3 * c4[3]; }
            }
#pragma unroll
            for (int j = 0; j < 33; ++j) red[(ks * 33 + j) * 128 + nn] = a[j];
            __syncthreads();
            for (int i = F.tid; i < 33 * 128; i += NT) { const int j = i >> 7, n = i & 127;
                MODP[((size_t)(kq * 2 + layer) * 33 + j) * 6144 + ntile * 128 + n] = red[(0 * 33 + j) * 128 + n] + red[(1 * 33 + j) * 128 + n] + red[(2 * 33 + j) * 128 + n] + red[(3 * 33 + j) * 128 + n]; }
        }
        __syncthreads();
    }
}

__device__ __forceinline__ void phase_mod0(const Frame& F) {
    const float* MODP = WSP(float, WS_MODP); float* MOD = WSP(float, WS_MOD);
    for (int i = F.bx * NT + F.tid; i < 2 * 33 * 6144; i += F.G * NT) {
        const int layer = i / (33 * 6144), n = i % 6144;
        MOD[i] = F.in[5][layer * 6144 + n] + MODP[i] + MODP[(size_t)2 * 33 * 6144 + i] + MODP[(size_t)4 * 33 * 6144 + i] + MODP[(size_t)6 * 33 * 6144 + i];
    }
    bf16_t* H = WSP(bf16_t, WS_HA);
    const int gw = F.bx * 8 + F.wid, nw = F.G * 8;
    const int per = (NROWS + nw - 1) / nw;
    int curj = -1; f32x4 sh[4], sc[4];
    for (int r = gw * per; r < (gw + 1) * per && r < NROWS; r += 4) {
        const int b = r / SPB, s = r % SPB; const int j = s < 256 ? 32 : b;
        if (j != curj) { curj = j;
#pragma unroll
            for (int i = 0; i < 4; ++i) { const int c = F.lane * 4 + 256 * i; f32x4 a = *(const f32x4*)(F.in[5] + c), bq = *(const f32x4*)(F.in[5] + 1024 + c);
#pragma unroll
                for (int q = 0; q < 4; ++q) { a += *(const f32x4*)(MODP + ((size_t)(q * 2) * 33 + j) * 6144 + c); bq += *(const f32x4*)(MODP + ((size_t)(q * 2) * 33 + j) * 6144 + 1024 + c); }
                sh[i] = a; sc[i] = bq; } }
        f32x4 x[4][4];
#pragma unroll
        for (int q = 0; q < 4; ++q) { const int sq = s + q; const float* src = sq < 256 ? F.in[2] + ((size_t)b * CTXL + sq) * 1024 : F.in[0] + ((size_t)b * SEQ + sq - 256) * 1024;
#pragma unroll
            for (int i = 0; i < 4; ++i) x[q][i] = *(const f32x4*)(src + F.lane * 4 + 256 * i); }
#pragma unroll
        for (int q = 0; q < 4; ++q)
#pragma unroll
            for (int i = 0; i < 4; ++i) { const int c = F.lane * 4 + 256 * i; const f32x4 h = x[q][i] * (sc[i] + 1.f) + sh[i];
                u32x2 w; w.x = cvt_pk_bf16(h[0], h[1]); w.y = cvt_pk_bf16(h[2], h[3]); *(u32x2*)(H + (size_t)(r + q) * 1024 + c) = w; }
    }
}

__device__ __forceinline__ void phase_post0(const Frame& F) {
    bf16_t* PB = WSP(bf16_t, WS_R + R_PB);
    const int gw = F.bx * 8 + F.wid, nw = F.G * 8; const int per = (NROWS + nw - 1) / nw;
    const int l = F.lane;
    float ga[8], gb[8];
#pragma unroll
    for (int e = 0; e < 8; ++e) { ga[e] = F.in[16][l * 8 + e]; gb[e] = F.in[17][l * 8 + e]; }
    const int j = l & 7; const bool isq = l < 32;
    float gn[16];
#pragma unroll
    for (int e = 0; e < 16; ++e) gn[e] = (isq ? F.in[20] : F.in[21])[(16 * j + e) & 127];
    const int ax = j >> 2, hh = (j >> 1) & 1, f0 = (j & 1) * 16; const float sg = hh ? 1.f : -1.f;
    for (int r = gw * per; r < (gw + 1) * per && r < NROWS; ++r) {
        const int s = r % SPB;
        bf16_t* pa = PB + (size_t)r * 2048 + 512 + l * 8; bf16_t* pq = PB + (size_t)r * 2048 + 1024 + l * 16;
        const u32x4 ra = *(const u32x4*)pa; u32x4 rq0 = {0u, 0u, 0u, 0u}, rq1 = rq0;
        if (l < 48) { rq0 = *(const u32x4*)pq; rq1 = *(const u32x4*)(pq + 8); }
        {
            float v[8]; unpack8(ra, v); float sum = 0.f;
#pragma unroll
            for (int e = 0; e < 8; ++e) { v[e] = gelu_tanh(v[e]); sum += v[e]; }
#pragma unroll
            for (int o = 1; o < 64; o <<= 1) sum += __shfl_xor(sum, o);
            const float mu = sum * (1.f / 512.f); float q = 0.f;
#pragma unroll
            for (int e = 0; e < 8; ++e) { const float d = v[e] - mu; q += d * d; }
#pragma unroll
            for (int o = 1; o < 64; o <<= 1) q += __shfl_xor(q, o);
            const float rstd = rsqrtf(q * (1.f / 512.f) + EPSN);
#pragma unroll
            for (int e = 0; e < 8; ++e) v[e] = (v[e] - mu) * rstd * ga[e] + gb[e];
            *(u32x4*)pa = pack8(v);
        }
        if (l < 48) {
            float v[16]; unpack8(rq0, v); unpack8(rq1, v + 8); float ss = 0.f;
#pragma unroll
            for (int e = 0; e < 16; ++e) ss += v[e] * v[e];
            ss += __shfl_xor(ss, 1); ss += __shfl_xor(ss, 2); ss += __shfl_xor(ss, 4);
            const float rstd = rsqrtf(ss * (1.f / 128.f) + EPSN);
#pragma unroll
            for (int e = 0; e < 16; ++e) v[e] = v[e] * rstd * gn[e];
            const bool lat = s >= 256; const int t = s - 256;
            const int pos = lat ? (ax ? (t & 63) : (t >> 6)) : 0;
            const f32x4* rt = (const f32x4*)(WSP(const f32x2, WS_ROPE) + pos * 32 + f0);
#pragma unroll
            for (int e = 0; e < 16; e += 2) {
                const float o0 = __shfl_xor(v[e], 2), o1 = __shfl_xor(v[e + 1], 2);
                const f32x4 cs = rt[e >> 1];
                if (lat) { v[e] = v[e] * cs[0] + sg * o0 * cs[1]; v[e + 1] = v[e + 1] * cs[2] + sg * o1 * cs[3]; }
            }
            *(u32x4*)pq = pack8(v); *(u32x4*)(pq + 8) = pack8(v + 8);
        }
    }
}

__device__ __forceinline__ void phase_attn_gmlp(Frame& F) {
    const bf16_t* PB = WSP(bf16_t, WS_R + R_PB); bf16_t* AO = WSP(bf16_t, WS_HA);
#ifndef NO_ATTN
    for (int i = 0; ; ++i) {
        const int L = i * F.G + F.bx; if (L >= 1152) break;
        int b, h, qb, seq;
        if (L < 1024) { const int x = F.bx & 7, k = F.bx >> 3; b = (L / 256) * 8 + x; h = k >> 3; qb = 1 + (k & 7); seq = SPB; if (F.G != 256) { b = L >> 5; h = (L >> 3) & 3; qb = 1 + (L & 7); } }
        else { const int c = L - 1024; b = c >> 2; h = c & 3; qb = 0; seq = CTXL; }
        const size_t row0 = (size_t)b * SPB + qb * 256;
        __syncthreads();
        int t2 = F.tid; asm volatile("" : "+v"(t2));
        att::attn_dense_body(PB + row0 * 2048 + 1024 + h * 128, PB + (size_t)b * SPB * 2048 + 1536 + (h >> 1) * 128, PB + (size_t)b * SPB * 2048 + 1792 + (h >> 1) * 128,
                             AO + row0 * 1024 + 512 + h * 128, seq, (char*)F.lds, t2);
    }
#endif
    __syncthreads();
    { int tid = F.tid; asm volatile("" : "+v"(tid)); F.tid = tid; F.lane = tid & 63; F.wid = __builtin_amdgcn_readfirstlane(tid >> 6); }
#ifndef NO_GMLP
    const bf16_t* Gw = WSP(const bf16_t, WS_GWS);
    char* WSl = (char*)F.lds; char* VT = WSl + 32768;
    const int fr = F.lane & 15, fq = F.lane >> 4, w = F.wid;
    for (int u = F.bx; u < 576 * 4; u += F.G) {
        const int g = u & 3, ch = u >> 2; const size_t R0 = (size_t)ch * 128;
        __syncthreads();
#pragma unroll
        for (int i = 0; i < 4; ++i) { const int id = F.tid + NT * i, row = id >> 4, c16 = id & 15;
            *(u32x4*)(WSl + KSWZ(row, c16 * 16)) = *(const u32x4*)(Gw + (size_t)g * 16384 + row * 128 + c16 * 8);
            const u32x4 vv = *(const u32x4*)(PB + (R0 + row) * 2048 + 512 + g * 128 + c16 * 8);
            const unsigned wv[4] = {vv.x, vv.y, vv.z, vv.w};
#pragma unroll
            for (int e = 0; e < 8; ++e) { const int d = c16 * 8 + e; const unsigned short hv = (unsigned short)((e & 1) ? (wv[e >> 1] >> 16) : (wv[e >> 1] & 0xffffu));
                *(unsigned short*)(VT + KSWZ(d, row * 2)) = hv; }
        }
        __syncthreads();
        bf16x8 af[4];
#pragma unroll
        for (int k = 0; k < 4; ++k) af[k] = *(const bf16x8*)(WSl + KSWZ(w * 16 + fr, (k * 32 + fq * 8) * 2));
        const int p = w * 16 + fr; const float bsv = F.in[19][g * 128 + p];
        const size_t R = R0 + p;
#pragma unroll
        for (int dt = 0; dt < 8; ++dt) {
            f32x4 acc = {0.f, 0.f, 0.f, 0.f};
#pragma unroll
            for (int k = 0; k < 4; ++k) { const bf16x8 bfr = *(const bf16x8*)(VT + KSWZ(dt * 16 + fr, (k * 32 + fq * 8) * 2)); acc = __builtin_amdgcn_mfma_f32_16x16x32_bf16(bfr, af[k], acc, 0, 0, 0); }
            const int col = g * 128 + dt * 16 + 4 * fq;
            const u32x2 uu = *(const u32x2*)(PB + R * 2048 + col);
            const float o0 = gelu_tanh(bflo(uu.x)) * (acc[0] + bsv), o1 = gelu_tanh(bfhi(uu.x)) * (acc[1] + bsv), o2 = gelu_tanh(bflo(uu.y)) * (acc[2] + bsv), o3 = gelu_tanh(bfhi(uu.y)) * (acc[3] + bsv);
            u32x2 wv; wv.x = cvt_pk_bf16(o0, o1); wv.y = cvt_pk_bf16(o2, o3); *(u32x2*)(AO + R * 1024 + col) = wv;
        }
    }
    __syncthreads();
#endif
}

struct LnDesc { const float* g; const float* b; const float* modn; int sh_off, sc_off; int latent_only; int final_out; int hbnd; int write_xl; };
__device__ __forceinline__ void phase_ln(const Frame& F, const LnDesc& d) {
    const bf16_t* XL = WSP(const bf16_t, WS_XL); bf16_t* H = WSP(bf16_t, WS_HA); bf16_t* HB_ = WSP(bf16_t, WS_R + R_HBND); float* ST = WSP(float, WS_STATS);
    const int total = d.latent_only ? NB * SEQ : NROWS;
    const int gw = F.bx * 8 + F.wid, nw = F.G * 8; const int per = (total + nw - 1) / nw;
    float gg[16], bb[16], sh[16], sc[16]; int curj = -1;
#pragma unroll
    for (int i = 0; i < 2; ++i)
#pragma unroll
        for (int e = 0; e < 8; ++e) { const int c = F.lane * 8 + 512 * i + e; gg[i * 8 + e] = d.g[c]; bb[i * 8 + e] = d.b[c]; sh[i * 8 + e] = 0.f; sc[i * 8 + e] = 0.f; }
    const int iend = ((gw + 1) * per < total) ? (gw + 1) * per : total;
    for (int idx0 = gw * per; idx0 < iend; idx0 += 8) {
        u32x4 xr[8][2]; int rr[8], rb[8], rs[8];
#pragma unroll
        for (int q = 0; q < 8; ++q) { const int idx = (idx0 + q < iend) ? idx0 + q : iend - 1;
            if (d.latent_only) { rb[q] = idx >> 11; rs[q] = 256 + (idx & 2047); rr[q] = rb[q] * SPB + rs[q]; } else { rr[q] = idx; rb[q] = idx / SPB; rs[q] = idx % SPB; }
            const bf16_t* xp = XL + (size_t)rr[q] * 1024 + F.lane * 8;
            xr[q][0] = *(const u32x4*)(xp); xr[q][1] = *(const u32x4*)(xp + 512); }
#pragma unroll
        for (int q = 0; q < 8; ++q) {
            if (idx0 + q >= iend) break;
            const int r = rr[q], b = rb[q], s = rs[q]; float x[16]; float sum = 0.f;
            unpack8(xr[q][0], x); unpack8(xr[q][1], x + 8);
#pragma unroll
            for (int e = 0; e < 16; ++e) sum += x[e];
#pragma unroll
            for (int o = 1; o < 64; o <<= 1) sum += __shfl_xor(sum, o);
            const float mu = sum * (1.f / 1024.f); float qq = 0.f;
#pragma unroll
            for (int e = 0; e < 16; ++e) { const float dd = x[e] - mu; qq += dd * dd; }
#pragma unroll
            for (int o = 1; o < 64; o <<= 1) qq += __shfl_xor(qq, o);
            const float rstd = rsqrtf(qq * (1.f / 1024.f) + EPSN);
            if (!d.final_out && F.lane == 0) *(f32x2*)(ST + (size_t)r * 2) = (f32x2){mu, rstd};
            int bidx = -1;
            if (d.hbnd && s >= 256) { const int l = s - 256; if ((l & 255) == 255 && l != SEQ - 1) bidx = (b * 7 + (l >> 8)) * 2; else if ((l & 255) == 0 && l != 0) bidx = (b * 7 + (l >> 8) - 1) * 2 + 1; }
            if (!d.final_out) { const int j = s < 256 ? 32 : b;
                if (j != curj) { curj = j;
#pragma unroll
                    for (int i = 0; i < 2; ++i) { const float* mp = d.modn + (size_t)j * 6144 + F.lane * 8 + 512 * i;
                        const f32x4 a0 = *(const f32x4*)(mp + d.sh_off), a1 = *(const f32x4*)(mp + d.sh_off + 4), c0 = *(const f32x4*)(mp + d.sc_off), c1 = *(const f32x4*)(mp + d.sc_off + 4);
#pragma unroll
                        for (int e = 0; e < 4; ++e) { sh[i * 8 + e] = a0[e]; sh[i * 8 + 4 + e] = a1[e]; sc[i * 8 + e] = c0[e]; sc[i * 8 + 4 + e] = c1[e]; } } } }
            float y[16];
#pragma unroll
            for (int e = 0; e < 16; ++e) y[e] = (x[e] - mu) * rstd * gg[e] + bb[e];
            if (d.final_out) {
                float* op = F.out + ((size_t)b * SEQ + (s - 256)) * 1024 + F.lane * 8;
#pragma unroll
                for (int i = 0; i < 2; ++i) { *(f32x4*)(op + 512 * i) = (f32x4){y[i * 8 + 0], y[i * 8 + 1], y[i * 8 + 2], y[i * 8 + 3]}; *(f32x4*)(op + 512 * i + 4) = (f32x4){y[i * 8 + 4], y[i * 8 + 5], y[i * 8 + 6], y[i * 8 + 7]}; }
            } else {
                float h[16];
#pragma unroll
                for (int e = 0; e < 16; ++e) h[e] = y[e] * (sc[e] + 1.f) + sh[e];
#pragma unroll
                for (int i = 0; i < 2; ++i) { const u32x4 w = pack8(h + i * 8); *(u32x4*)(H + (size_t)r * 1024 + F.lane * 8 + 512 * i) = w; if (bidx >= 0) *(u32x4*)(HB_ + (size_t)bidx * 1024 + F.lane * 8 + 512 * i) = w; }
            }
        }
    }
}

#define XB_TMO      128
#define XB_XCNT(j)  (256  + 64 * (j))
#define XB_XSUB(j)  (1280 + 64 * (j))
#define XB_XGEN(j)  (2304 + 64 * (j))
#define XB_TOP      3328
#define XB_TOPGEN   3392
#define XCD_BAR_WORDS 3456
#define XB_SPIN_CAP (1u << 18)

__device__ __forceinline__ unsigned xb_ld(unsigned* p)              { return __hip_atomic_load(p, __ATOMIC_RELAXED, __HIP_MEMORY_SCOPE_AGENT); }
__device__ __forceinline__ unsigned xb_add(unsigned* p, unsigned v) { return __hip_atomic_fetch_add(p, v, __ATOMIC_RELAXED, __HIP_MEMORY_SCOPE_AGENT); }
__device__ __forceinline__ unsigned xb_xcc_id() { return (unsigned)__builtin_amdgcn_s_getreg((3 << 11) | 20) & 0xFu; }
#define XB_SPIN(cond, bar) do { unsigned _sp = 0; while (cond) { __builtin_amdgcn_s_sleep(1); \
    if ((++_sp & 255u) == 0u) { if (xb_ld(&(bar)[XB_TMO])) break; if (_sp > XB_SPIN_CAP) { atomicAdd(&(bar)[XB_TMO], 1u); break; } } } } while (0)

struct XcdBarrier {
    unsigned* bar; unsigned x;
    volatile LAS unsigned* st;
};

__device__ __forceinline__ XcdBarrier xcd_barrier_post(unsigned* bar, volatile LAS unsigned* st) {
    XcdBarrier b; b.bar = bar; b.x = xb_xcc_id(); b.st = st;
    if (threadIdx.x == 0) (void)xb_add(&bar[XB_XCNT(b.x)], 1u);
    return b;
}
__device__ __forceinline__ void xcd_barrier_complete(unsigned* bar, unsigned x, unsigned& nloc, unsigned& nx) {
    const unsigned G = gridDim.x * gridDim.y * gridDim.z;
    unsigned sum, cnt, mine, sp = 0u;
    for (;;) {
        sum = 0u; cnt = 0u; mine = 0u;
#pragma unroll
        for (unsigned j = 0; j < 16; ++j) { const unsigned c = xb_ld(&bar[XB_XCNT(j)]); sum += c; cnt += (c > 0u) ? 1u : 0u; mine = (j == x) ? c : mine; }
        if (sum == G) break;
        __builtin_amdgcn_s_sleep(1);
        if ((++sp & 255u) == 0u) { if (xb_ld(&bar[XB_TMO])) break; if (sp > XB_SPIN_CAP) { atomicAdd(&bar[XB_TMO], 1u); break; } }
    }
    nloc = mine > 0u ? mine : 1u; nx = cnt > 0u ? cnt : 1u;
}

__device__ __forceinline__ void xcd_barrier(const XcdBarrier& b) {
    asm volatile("s_waitcnt vmcnt(0)" ::: "memory");
    __syncthreads();
    if (threadIdx.x == 0) {
        unsigned* bar = b.bar;
        __builtin_amdgcn_s_waitcnt(0);
        unsigned nloc = b.st[0], nx = b.st[1];
        if (nloc == 0u) { xcd_barrier_complete(bar, b.x, nloc, nx); b.st[0] = nloc; b.st[1] = nx; }
        const unsigned old = xb_add(&bar[XB_XSUB(b.x)], 1u);
        const unsigned gen = old / nloc;
        if (old + 1u == (gen + 1u) * nloc) {
            __builtin_amdgcn_fence(__ATOMIC_RELEASE, "agent");
            asm volatile("s_waitcnt vmcnt(0)" ::: "memory");
            const unsigned og = xb_add(&bar[XB_TOP], 1u);
            const unsigned tg = og / nx;
            if (og + 1u == (tg + 1u) * nx) xb_add(&bar[XB_TOPGEN], 1u);
            else XB_SPIN(xb_ld(&bar[XB_TOPGEN]) == tg, bar);
            __builtin_amdgcn_fence(__ATOMIC_ACQUIRE, "agent");
            xb_add(&bar[XB_XGEN(b.x)], 1u);
            asm volatile("s_waitcnt vmcnt(0)" ::: "memory");
        } else {
            XB_SPIN(xb_ld(&bar[XB_XGEN(b.x)]) == gen, bar);
            __builtin_amdgcn_fence(__ATOMIC_ACQUIRE, "agent");
            asm volatile("s_waitcnt vmcnt(0)" ::: "memory");
        }
    }
    __syncthreads();
}


__device__ __forceinline__ void phase_xconv(const Frame& F, const XcdBarrier& xbar) {
    bf16_t* P1 = WSP(bf16_t, WS_R + R_P1);
    const int gw = F.bx * 8 + F.wid, nw = F.G * 8; const int per = NROWS / nw;
    const int ra = gw * per; const int c0 = F.lane * 16;
    bf16_t* base = P1 + 512 + c0;
    const u32x4 z4 = {0u, 0u, 0u, 0u};
    u32x4 win[6][2];
    u32x4 edge[2];
    if (ra > 0) { win[0][0] = *(const u32x4*)(base + (size_t)(ra - 1) * 1536); win[0][1] = *(const u32x4*)(base + (size_t)(ra - 1) * 1536 + 8); } else { win[0][0] = z4; win[0][1] = z4; }
    if (ra + per < NROWS) { edge[0] = *(const u32x4*)(base + (size_t)(ra + per) * 1536); edge[1] = *(const u32x4*)(base + (size_t)(ra + per) * 1536 + 8); } else { edge[0] = z4; edge[1] = z4; }
    asm volatile("" : "+v"(win[0][0]), "+v"(win[0][1]), "+v"(edge[0]), "+v"(edge[1]));
    xcd_barrier(xbar);
    float w0[16], w1[16], w2[16], wb[16];
#pragma unroll
    for (int e = 0; e < 16; ++e) { w0[e] = F.in[24][c0 + e]; w1[e] = F.in[24][1024 + c0 + e]; w2[e] = F.in[24][2048 + c0 + e]; wb[e] = F.in[25][c0 + e]; }
    win[1][0] = *(const u32x4*)(base + (size_t)ra * 1536); win[1][1] = *(const u32x4*)(base + (size_t)ra * 1536 + 8);
#pragma unroll 1
    for (int g4 = 0; g4 < per; g4 += 4) {
        const int r0 = ra + g4;
#pragma unroll
        for (int q = 2; q < 6; ++q) {
            const int rr = r0 + q - 1;
            if (rr < ra + per) { win[q][0] = *(const u32x4*)(base + (size_t)rr * 1536); win[q][1] = *(const u32x4*)(base + (size_t)rr * 1536 + 8); } else { win[q][0] = edge[0]; win[q][1] = edge[1]; }
        }
#pragma unroll
        for (int q = 1; q < 5; ++q) {
            const int r = r0 + q - 1; const int sidx = r % SPB;
            const bool pv = (sidx != 0 && sidx != 256), nv = (sidx != 255 && sidx != SPB - 1);
            float o[16];
#pragma unroll
            for (int hlf = 0; hlf < 2; ++hlf) {
                float pr[8], cu[8], nx[8];
                unpack8(win[q - 1][hlf], pr); unpack8(win[q][hlf], cu); unpack8(win[q + 1][hlf], nx);
#pragma unroll
                for (int e = 0; e < 8; ++e) o[hlf * 8 + e] = silu_f(wb[hlf * 8 + e] + (pv ? w0[hlf * 8 + e] * pr[e] : 0.f) + w1[hlf * 8 + e] * cu[e] + (nv ? w2[hlf * 8 + e] * nx[e] : 0.f));
            }
            *(u32x4*)(base + (size_t)r * 1536) = pack8(o); *(u32x4*)(base + (size_t)r * 1536 + 8) = pack8(o + 8);
        }
        win[0][0] = win[4][0]; win[0][1] = win[4][1]; win[1][0] = win[5][0]; win[1][1] = win[5][1];
    }
}


__device__ __forceinline__ void phase_ssd(const Frame& F) {
    const bf16_t* P1 = WSP(const bf16_t, WS_R + R_P1); const float* DTb = WSP(const float, WS_R + R_DT);
    bf16_t* YF = WSP(bf16_t, WS_R + R_YF); bf16_t* YB = WSP(bf16_t, WS_R + R_YB);
    char* Cm = (char*)F.lds; char* Bm = Cm + 32768; char* BTW = Cm + 65536; char* XT = Cm + 98304; char* HB = Cm + 114688;
    float* dts = (float*)(Cm + 131072); float* acs = dts + 128; float* wts = acs + 128;
    const int fr = F.lane & 15, fq = F.lane >> 4, w = F.wid;
    for (int item = F.bx; item < NB * 16; item += F.G) {
        const int b = item >> 4, hh = (item >> 1) & 7, dir = item & 1, g = hh >> 2;
        const float aneg = -__expf(F.in[27][dir * 8 + hh]); const float dtbias = F.in[26][dir * 8 + hh]; const float dsk = F.in[28][hh];
        const int scgp = F.tid % 40, spblk = F.tid / 40;
        const int sxc = scgp < 8 ? hh * 64 + scgp * 8 : (scgp < 24 ? 512 + g * 128 + (scgp - 8) * 8 : 768 + g * 128 + (scgp - 24) * 8);
        f32x4 hst[4];
#pragma unroll
        for (int i = 0; i < 4; ++i) hst[i] = (f32x4){0.f, 0.f, 0.f, 0.f};
        __syncthreads();
        for (int i = F.tid; i < 16384 / 4; i += NT) ((unsigned*)HB)[i] = 0u;
        for (int step = 0; step < 18; ++step) {
            const int cc = dir ? (step < 2 ? 1 - step : 19 - step) : step;
            const bool isctx = cc < 2; const int s0 = cc * 128; const size_t R0 = (size_t)b * SPB + s0;
            __syncthreads();
            if (w == 7) {
                const int t0 = 2 * F.lane, t1 = t0 + 1; const int p0 = dir ? 127 - t0 : t0, p1 = dir ? 127 - t1 : t1;
                const float d0 = softplus_f(DTb[(R0 + p0) * 16 + dir * 8 + hh] + dtbias), d1 = softplus_f(DTb[(R0 + p1) * 16 + dir * 8 + hh] + dtbias);
                const float v0 = d0 * aneg, v1 = d1 * aneg; const float sp = v0 + v1; float sc = sp;
#pragma unroll
                for (int o = 1; o < 64; o <<= 1) { const float y = __shfl_up(sc, o); if (F.lane >= o) sc += y; }
                const float tot = __shfl(sc, 63); const float pre = sc - sp; const float a0 = pre + v0, a1 = pre + sp;
                dts[t0] = d0; dts[t1] = d1; acs[t0] = a0; acs[t1] = a1; wts[t0] = d0 * __expf(tot - a0); wts[t1] = d1 * __expf(tot - a1);
            }
            const bool act_stg = (F.tid < 320) && !(isctx && scgp >= 24);
#pragma unroll 1
            for (int rd = 0; rd < 2; ++rd) {
                u32x4 outp[8];
                const int p0 = (spblk * 2 + rd) * 8;
                if (act_stg) {
                    const char* rb = (const char*)(P1 + R0 * 1536);
                    const unsigned voff = (unsigned)(p0 * 1536 + 512 + sxc) * 2u;
#pragma unroll
                    for (int i = 0; i < 8; ++i) outp[i] = *(const u32x4*)(rb + i * 3072 + voff);
                }
                if (rd == 0) __syncthreads();
                if (act_stg) {
                    if (scgp >= 8) {
                        char* dstm = (scgp < 24) ? Bm : Cm; const int n = ((scgp < 24) ? (scgp - 8) : (scgp - 24)) * 8;
#pragma unroll
                        for (int i = 0; i < 8; ++i) { const int t = dir ? 127 - (p0 + i) : p0 + i; *(u32x4*)(dstm + KSWZ(t, n * 2)) = outp[i]; }
                    }
                    if (scgp < 24) {
                        char* dstt = (scgp < 8) ? XT : BTW; const int rowb = ((scgp < 8) ? scgp : (scgp - 8)) * 8; const bool scale = scgp >= 8;
                        float wv[8];
#pragma unroll
                        for (int i = 0; i < 8; ++i) { const int t = dir ? 127 - (p0 + i) : p0 + i; wv[i] = scale ? wts[t] : 1.f; }
                        const int tb = dir ? 120 - p0 : p0;
#pragma unroll
                        for (int e = 0; e < 8; ++e) {
                            float v[8];
#pragma unroll
                            for (int i = 0; i < 8; ++i) { const unsigned wd = (e >> 1) == 0 ? outp[i].x : ((e >> 1) == 1 ? outp[i].y : ((e >> 1) == 2 ? outp[i].z : outp[i].w)); v[i] = ((e & 1) ? bfhi(wd) : bflo(wd)) * wv[i]; }
                            u32x4 lo;
                            if (!dir) { lo.x = cvt_pk_bf16(v[0], v[1]); lo.y = cvt_pk_bf16(v[2], v[3]); lo.z = cvt_pk_bf16(v[4], v[5]); lo.w = cvt_pk_bf16(v[6], v[7]); }
                            else      { lo.x = cvt_pk_bf16(v[7], v[6]); lo.y = cvt_pk_bf16(v[5], v[4]); lo.z = cvt_pk_bf16(v[3], v[2]); lo.w = cvt_pk_bf16(v[1], v[0]); }
                            *(u32x4*)(dstt + KSWZ(rowb + e, tb * 2)) = lo;
                            __builtin_amdgcn_sched_barrier(0);
                        }
                    }
                }
            }
            __syncthreads();
            if (!isctx) {
                const int t = w * 16 + fr; const float act = acs[t];
                bf16x8 cf[4];
#pragma unroll
                for (int k = 0; k < 4; ++k) cf[k] = *(const bf16x8*)(Cm + KSWZ(t, (k * 32 + fq * 8) * 2));
                f32x4 mv[8];
#pragma unroll
                for (int st = 0; st < 8; ++st) {
                    f32x4 acc = {0.f, 0.f, 0.f, 0.f};
                    if (st <= w) {
#pragma unroll
                        for (int k = 0; k < 4; ++k) { const bf16x8 bfr = *(const bf16x8*)(Bm + KSWZ(st * 16 + fr, (k * 32 + fq * 8) * 2)); acc = __builtin_amdgcn_mfma_f32_16x16x32_bf16(bfr, cf[k], acc, 0, 0, 0); }
                        const int sb = st * 16 + 4 * fq; const f32x4 as = *(const f32x4*)(acs + sb), ds = *(const f32x4*)(dts + sb);
#pragma unroll
                        for (int r = 0; r < 4; ++r) acc[r] = (sb + r <= t) ? acc[r] * __expf(act - as[r]) * ds[r] : 0.f;
                    }
                    mv[st] = acc;
                }
                __syncthreads();
#pragma unroll
                for (int st = 0; st < 8; ++st) { u32x2 wv; wv.x = cvt_pk_bf16(mv[st][0], mv[st][1]); wv.y = cvt_pk_bf16(mv[st][2], mv[st][3]); *(u32x2*)(Bm + KSWZ(t, (st * 16 + 4 * fq) * 2)) = wv; }
                __syncthreads();
                bf16x8 mf[4];
#pragma unroll
                for (int k = 0; k < 4; ++k) mf[k] = *(const bf16x8*)(Bm + KSWZ(t, (k * 32 + fq * 8) * 2));
                const float eact = __expf(act);
                const int pos = dir ? 127 - t : t; const size_t li = (size_t)b * SEQ + (size_t)(cc - 2) * 128 + pos;
                bf16_t* Y = (dir ? YB : YF) + li * 512 + hh * 64;
#pragma unroll
                for (int pt = 0; pt < 4; ++pt) {
                    f32x4 yd = {0.f, 0.f, 0.f, 0.f}, yo = {0.f, 0.f, 0.f, 0.f};
#pragma unroll
                    for (int k = 0; k < 4; ++k) {
                        const bf16x8 xf = *(const bf16x8*)(XT + KSWZ(pt * 16 + fr, (k * 32 + fq * 8) * 2)); yd = __builtin_amdgcn_mfma_f32_16x16x32_bf16(xf, mf[k], yd, 0, 0, 0);
                        const bf16x8 hf = *(const bf16x8*)(HB + KSWZ(pt * 16 + fr, (k * 32 + fq * 8) * 2)); yo = __builtin_amdgcn_mfma_f32_16x16x32_bf16(hf, cf[k], yo, 0, 0, 0);
                    }
                    float yv[4];
#pragma unroll
                    for (int r = 0; r < 4; ++r) { yv[r] = yd[r] + eact * yo[r]; if (!dir) yv[r] += dsk * bf2f(*(const bf16_t*)(XT + KSWZ(pt * 16 + 4 * fq + r, t * 2))); }
                    u32x2 wv; wv.x = cvt_pk_bf16(yv[0], yv[1]); wv.y = cvt_pk_bf16(yv[2], yv[3]); *(u32x2*)(Y + pt * 16 + 4 * fq) = wv;
                }
            }
            __syncthreads();
            {
                const float dec = __expf(acs[127]); const int ptile = w & 3, nb = (w >> 2) * 4;
                bf16x8 xf[4];
#pragma unroll
                for (int k = 0; k < 4; ++k) xf[k] = *(const bf16x8*)(XT + KSWZ(ptile * 16 + fr, (k * 32 + fq * 8) * 2));
#pragma unroll
                for (int i = 0; i < 4; ++i) { f32x4 acc = hst[i] * dec;
#pragma unroll
                    for (int k = 0; k < 4; ++k) { const bf16x8 bfr = *(const bf16x8*)(BTW + KSWZ((nb + i) * 16 + fr, (k * 32 + fq * 8) * 2)); acc = __builtin_amdgcn_mfma_f32_16x16x32_bf16(bfr, xf[k], acc, 0, 0, 0); }
                    hst[i] = acc;
                    u32x2 wv; wv.x = cvt_pk_bf16(acc[0], acc[1]); wv.y = cvt_pk_bf16(acc[2], acc[3]); *(u32x2*)(HB + KSWZ(ptile * 16 + fr, ((nb + i) * 16 + 4 * fq) * 2)) = wv; }
            }
        }
    }
    __syncthreads();
}

__device__ __forceinline__ void phase_ssdout(const Frame& F) {
    const bf16_t* P1 = WSP(const bf16_t, WS_R + R_P1); const bf16_t* YF = WSP(const bf16_t, WS_R + R_YF); const bf16_t* YB = WSP(const bf16_t, WS_R + R_YB); bf16_t* AO = WSP(bf16_t, WS_HA);
    const int total = NB * SEQ; const int gw = F.bx * 8 + F.wid, nw = F.G * 8; const int per = (total + nw - 1) / nw;
    float gn[8];
#pragma unroll
    for (int e = 0; e < 8; ++e) gn[e] = F.in[29][F.lane * 8 + e];
    for (int idx = gw * per; idx < (gw + 1) * per && idx < total; ++idx) {
        const int b = idx >> 11, l = idx & 2047; const size_t r = (size_t)b * SPB + 256 + l;
        float yf[8], yb[8], z[8], y[8]; unpack8(*(const u32x4*)(YF + (size_t)idx * 512 + F.lane * 8), yf); unpack8(*(const u32x4*)(YB + (size_t)idx * 512 + F.lane * 8), yb); unpack8(*(const u32x4*)(P1 + r * 1536 + F.lane * 8), z);
        float ss = 0.f;
#pragma unroll
        for (int e = 0; e < 8; ++e) { y[e] = (yf[e] + yb[e]) * silu_f(z[e]); ss += y[e] * y[e]; }
#pragma unroll
        for (int o = 1; o < 64; o <<= 1) ss += __shfl_xor(ss, o);
        const float rstd = rsqrtf(ss * (1.f / 512.f) + EPSN);
#pragma unroll
        for (int e = 0; e < 8; ++e) y[e] = y[e] * rstd * gn[e];
        *(u32x4*)(AO + r * 1024 + 512 + F.lane * 8) = pack8(y);
    }
}

constexpr int NPHASE = 22;
#ifndef PHMASK
#define PHMASK 0xFFFFFFFFFFull
#endif
#define PHON(k) ((PHMASK >> (k)) & 1ull)
__device__ __forceinline__ bool sync_after(int ph) { return !(ph == 11); }

__global__ void __launch_bounds__(NT, 2) mega_fwd(Params P) {
    extern __shared__ __attribute__((aligned(16))) unsigned char lds_raw[];
    Frame F; F.wid0 = __builtin_amdgcn_readfirstlane(threadIdx.x >> 6);
    cg::grid_group grid = cg::this_grid();
    volatile LAS unsigned* bst = (volatile LAS unsigned*)((LAS unsigned char*)lds_raw + LDS_BYTES - 16);
    if (threadIdx.x < 4) bst[threadIdx.x] = 0u;
    __syncthreads();
    XcdBarrier xbar = xcd_barrier_post((unsigned*)(P.ws + WS_BAR), bst);
    if (P.ph_hi > 1000) grid.sync();
    const int ph_lo = MK_MULTI ? P.ph_lo : 0, ph_hi = MK_MULTI ? P.ph_hi : NPHASE;
    for (int ph = ph_lo; ph < ph_hi; ++ph) {
#define RF() frame_refresh(F, P.in, P.ws, P.out, lds_raw)
#define MOD (WSP(const float, WS_MOD))
        bool is_gemm = false; pg8::Desc g{};
        if (ph == 0) { if (PHON(0)) { RF(); phase_prep(F); } }
        else if (ph == 1) { if (PHON(1)) { RF(); phase_mod0(F); } }
        else if (ph == 3) { if (PHON(3)) { RF(); phase_post0(F); } }
        else if (ph == 4) { if (PHON(4)) { RF(); phase_attn_gmlp(F); } }
        else if (ph == 6 || ph == 10 || ph == 17 || ph == 21) {
            RF(); LnDesc d{};
            const int layer = (ph >= 17) ? 1 : 0; const int second = (ph == 10 || ph == 21);
            d.g = F.in[second ? 8 : 6] + layer * 1024; d.b = F.in[second ? 9 : 7] + layer * 1024;
            d.latent_only = layer; d.final_out = (ph == 21); d.hbnd = (ph == 6 || ph == 17); d.write_xl = 0;
            if (ph == 6) { d.modn = MOD; d.sh_off = 3072; d.sc_off = 4096; }
            else if (ph == 10) { d.modn = MOD + 33 * 6144; d.sh_off = 0; d.sc_off = 1024; }
            else { d.modn = MOD + 33 * 6144; d.sh_off = 3072; d.sc_off = 4096; }
            if (PHON(6)) phase_ln(F, d);
        }
        else if (ph == 14) { if (PHON(14)) { RF(); phase_ssd(F); } }
        else if (ph == 15) { if (PHON(15)) { RF(); phase_ssdout(F); } }
        else {
            is_gemm = true; RF();
            g.xin = nullptr; g.cin = nullptr; g.DT = nullptr; g.gate = nullptr; g.a_local = 0; g.o_local = 0; g.b0 = 0; g.cw = nullptr; g.cb = nullptr; g.pbnd = nullptr; g.stats = nullptr; g.lng = nullptr; g.lnb = nullptr;
            if (ph == 2) { g.A = WSP(const bf16_t, WS_HA); g.Bt = WSP(const bf16_t, WS_W0IN); g.K = 1024; g.map = pg8::MAP_PLAIN; g.nM = NTILE; g.nN = 8; g.epi = pg8::EPI_BF16; g.perm = 1; g.O = WSP(void, WS_R + R_PB); g.ldc = 2048; }
            else if (ph == 5) { g.A = WSP(const bf16_t, WS_HA); g.Bt = WSP(const bf16_t, WS_W0OUT); g.K = 1024; g.map = pg8::MAP_PLAIN; g.nM = NTILE; g.nN = 4; g.epi = pg8::EPI_RES; g.perm = 1; g.O = WSP(void, WS_XL); g.ldc = 1024;
                g.gate = MOD + 2048; g.xin = F.in[0]; g.cin = F.in[2]; }
            else if (ph == 11) { g.A = WSP(const bf16_t, WS_W1F); g.Bt = WSP(const bf16_t, WS_HA); g.K = 1024; g.map = pg8::MAP_FSWAP; g.nM = 4; g.nN = 256; g.epi = pg8::EPI_BF16; g.perm = 1; g.O = WSP(void, WS_R + R_YT); g.ldc = 4096; }
            else if (ph == 12) { g.A = WSP(const bf16_t, WS_HA); g.Bt = WSP(const bf16_t, WS_W1IN); g.K = 1024; g.map = pg8::MAP_PLAIN; g.nM = NTILE; g.nN = 7; g.epi = pg8::EPI_BF16_DT; g.perm = 1; g.O = WSP(void, WS_R + R_P1); g.ldc = 1536; g.DT = WSP(float, WS_R + R_DT); }
            else if (ph == 13) { g.A = WSP(const bf16_t, WS_DFT); g.Bt = WSP(const bf16_t, WS_R + R_YT); g.K = 4096; g.map = pg8::MAP_DFT; g.nM = 256; g.nN = 2; g.epi = pg8::EPI_BF16; g.perm = 1; g.O = WSP(void, WS_HA); g.ldc = 1024; }
            else if (ph == 16) { g.A = WSP(const bf16_t, WS_HA); g.Bt = WSP(const bf16_t, WS_W1OUT); g.K = 1024; g.map = pg8::MAP_LATENT; g.nM = 256; g.nN = 4; g.epi = pg8::EPI_RES; g.perm = 1; g.O = WSP(void, WS_XL); g.ldc = 1024; g.gate = MOD + 33 * 6144 + 2048;
                g.stats = WSP(const float, WS_STATS); g.lng = F.in[8]; g.lnb = F.in[9]; }
            else {
                const int layer = ph >= 18 ? 1 : 0; const int which = ph - (layer ? 18 : 7);
                g.map = layer ? pg8::MAP_LATENT : pg8::MAP_PLAIN; g.nM = layer ? 256 : NTILE;
                if (which == 0) { g.A = WSP(const bf16_t, WS_R + R_HBND); g.Bt = WSP(const bf16_t, layer ? WS_WUP1 : WS_WUP0); g.K = 1024; g.map = pg8::MAP_RAW; g.nM = 2; g.nN = 22; g.epi = pg8::EPI_BF16; g.perm = 1; g.O = WSP(void, WS_R + R_PBND); g.ldc = DFF2; }
                else if (which == 1) { g.A = WSP(const bf16_t, WS_HA); g.Bt = WSP(const bf16_t, layer ? WS_WUP1 : WS_WUP0); g.K = 1024; g.nN = 22; g.epi = pg8::EPI_UPF; g.perm = 1; g.O = WSP(void, WS_R + R_G); g.ldc = DFF;
                    g.cw = F.in[11] + (size_t)layer * 3 * DFF2; g.cb = F.in[12] + (size_t)layer * DFF2; g.pbnd = WSP(const bf16_t, WS_R + R_PBND); }
                else { g.A = WSP(const bf16_t, WS_R + R_G); g.Bt = WSP(const bf16_t, layer ? WS_WDN1 : WS_WDN0); g.K = DFF; g.nN = 4; g.epi = pg8::EPI_RES; g.perm = 1; g.O = WSP(void, WS_XL); g.ldc = 1024;
                    g.gate = MOD + (size_t)layer * 33 * 6144 + 5120; g.stats = WSP(const float, WS_STATS); g.lng = F.in[6] + layer * 1024; g.lnb = F.in[7] + layer * 1024; }
            }
        }
        if (ph == 13 && PHON(13)) { RF(); phase_xconv(F, xbar); RF(); }
        if (is_gemm && PHON(2)) pg8::gemm_phase((LAS unsigned char*)F.lds, g, F.G, F.bx, F.tid);
        if (ph + 1 < ph_hi && sync_after(ph)) xcd_barrier(xbar);
    }
}

extern "C" void kernel_launch(void* const* d_in, const int* in_sizes, int n_in, void* d_out, int out_size, void* d_ws, size_t ws_size, hipStream_t stream) {
    static int grid = 0;
    if (grid == 0) {
        if (n_in != 30 || ws_size < WS_END) { fprintf(stderr, "kernel_launch: n_in %d ws %zu (need %zu)\n", n_in, ws_size, (size_t)WS_END); grid = -1; return; }
        int dev = 0, cus = 0, per_cu = 0;
        hipGetDevice(&dev); hipDeviceGetAttribute(&cus, hipDeviceAttributeMultiprocessorCount, dev);
        if (hipFuncSetAttribute((const void*)mega_fwd, hipFuncAttributeMaxDynamicSharedMemorySize, LDS_BYTES) != hipSuccess) { fprintf(stderr, "kernel_launch: hipFuncSetAttribute failed\n"); grid = -1; return; }
        hipOccupancyMaxActiveBlocksPerMultiprocessor(&per_cu, (const void*)mega_fwd, NT, LDS_BYTES);
        if (per_cu < 1) { fprintf(stderr, "kernel_launch: occupancy query says %d blocks per CU\n", per_cu); per_cu = 1; }
        (void)hipGetLastError();
        grid = cus * 1;
    }
    if (grid < 0) return;
    Params p{};
    for (int i = 0; i < 30; ++i) p.in[i] = (const float*)d_in[i];
    p.out = (float*)d_out; p.ws = (unsigned char*)d_ws;
#if MK_MULTI
    int lo = 0;
    for (int ph = 0; ph < NPHASE; ++ph) {
        if (ph + 1 == NPHASE || !(ph == 11)) { p.ph_lo = lo; p.ph_hi = ph + 1; lo = ph + 1;
            hipLaunchKernelGGL(mega_fwd, dim3(grid), dim3(NT), LDS_BYTES, stream, p); }
    }
#else
    p.ph_lo = 0; p.ph_hi = NPHASE;
    if (hipMemsetAsync((char*)d_ws + WS_BAR, 0, XCD_BAR_WORDS * sizeof(unsigned), stream) != hipSuccess) { fprintf(stderr, "kernel_launch: hipMemsetAsync failed\n"); return; }
    void* args[] = {&p};
    hipError_t e = hipLaunchCooperativeKernel((const void*)mega_fwd, dim3(grid), dim3(NT), args, LDS_BYTES, stream);
    if (e != hipSuccess) fprintf(stderr, "cooperative launch failed: %s (grid %d)\n", hipGetErrorString(e), grid);
#endif
}
```

```cpp
#include <hip/hip_runtime.h>
#include <hip/hip_cooperative_groups.h>
#include <cstdio>
#include <cstdint>
namespace cg = cooperative_groups;

#ifndef MK_MULTI
#define MK_MULTI 0
#endif

#define LAS __attribute__((address_space(3)))
typedef unsigned short bf16_t;
typedef short bf16x8 __attribute__((ext_vector_type(8)));
typedef short s16x4 __attribute__((ext_vector_type(4)));
typedef float f32x4 __attribute__((ext_vector_type(4)));
typedef float f32x2 __attribute__((ext_vector_type(2)));
typedef float f32x16 __attribute__((ext_vector_type(16)));
typedef unsigned u32x4 __attribute__((ext_vector_type(4)));
typedef unsigned u32x2 __attribute__((ext_vector_type(2)));

constexpr int DM = 1024, NB = 32, SEQ = 2048, CTXL = 256, SPB = 2304  , NROWS = NB * SPB, NTILE = NROWS / 256;
constexpr int DFF = 2816, DFF2 = 5632;
constexpr float EPSN = 1e-6f, DN_ALPHA = 1.41421356237309515f;
constexpr int NT = 512, LDS_BYTES = 144 * 1024;

constexpr size_t SZ_W0IN = (size_t)2048 * 1024 * 2, SZ_SQ = (size_t)1024 * 1024 * 2, SZ_WUP = (size_t)DFF2 * 1024 * 2, SZ_WDN = (size_t)1024 * DFF * 2;
constexpr size_t WS_W0IN = 0, WS_W0OUT = WS_W0IN + SZ_W0IN, WS_WUP0 = WS_W0OUT + SZ_SQ, WS_WUP1 = WS_WUP0 + SZ_WUP, WS_WDN0 = WS_WUP1 + SZ_WUP, WS_WDN1 = WS_WDN0 + SZ_WDN;
constexpr size_t WS_W1F = WS_WDN1 + SZ_WDN, WS_W1IN = WS_W1F + SZ_SQ, WS_W1OUT = WS_W1IN + (size_t)1792 * 1024 * 2, WS_DFT = WS_W1OUT + SZ_SQ;
constexpr size_t WS_GWS = WS_DFT + (size_t)2048 * 4096 * 2, WS_ROPE = WS_GWS + (size_t)4 * 128 * 128 * 2, WS_MODP = WS_ROPE + (size_t)64 * 32 * 8, WS_MOD = WS_MODP + (size_t)4 * 2 * 33 * 6144 * 4;
constexpr size_t WS_XL = WS_MOD + (size_t)2 * 33 * 6144 * 4, WS_HA = WS_XL + (size_t)NROWS * 1024 * 4, WS_R = WS_HA + (size_t)NROWS * 1024 * 2;
constexpr int CHUNK_ROWS_MAX = 11 * SPB;
constexpr size_t R_PB = 0;
constexpr size_t R_G = 0, R_HBND = R_G + (size_t)NROWS * DFF * 2, R_PBND = R_HBND + (size_t)512 * 1024 * 2;
constexpr size_t R_P1 = 0, R_YT = R_P1 + (size_t)NROWS * 1536 * 2, R_DT = R_YT + (size_t)NB * 512 * 4096 * 2, R_YF = R_DT + (size_t)NROWS * 16 * 4, R_YB = R_YF + (size_t)NB * SEQ * 512 * 2, R_END1 = R_YB + (size_t)NB * SEQ * 512 * 2;
constexpr size_t R_END0 = (size_t)NROWS * 2048 * 2, R_ENDF = R_PBND + (size_t)512 * DFF2 * 2;
constexpr size_t R_SIZE = (R_END1 > R_END0 ? (R_END1 > R_ENDF ? R_END1 : R_ENDF) : (R_END0 > R_ENDF ? R_END0 : R_ENDF));
constexpr size_t WS_BAR = WS_R + R_SIZE;
constexpr size_t WS_STATS = WS_BAR + 16384;
constexpr size_t WS_END = WS_STATS + (size_t)NROWS * 8;

struct Params { const float* in[30]; float* out; unsigned char* ws; int ph_lo, ph_hi; };

typedef __bf16 bf16x2_t __attribute__((ext_vector_type(2)));
__device__ __forceinline__ unsigned cvt_pk_bf16(float lo, float hi) { const f32x2 v = {lo, hi}; const bf16x2_t b = __builtin_convertvector(v, bf16x2_t); return __builtin_bit_cast(unsigned, b); }
__device__ __forceinline__ bf16_t f2bf(float f) { return (bf16_t)(cvt_pk_bf16(f, 0.f) & 0xffffu); }
__device__ __forceinline__ unsigned cvt_pk_bf16_asm(float lo, float hi) { unsigned r; asm volatile("v_cvt_pk_bf16_f32 %0, %1, %2" : "=v"(r) : "v"(lo), "v"(hi)); return r; }
__device__ __forceinline__ float bf2f(unsigned short b) { return __uint_as_float(((unsigned)b) << 16); }
__device__ __forceinline__ float bflo(unsigned w) { return __uint_as_float(w << 16); }
__device__ __forceinline__ float bfhi(unsigned w) { return __uint_as_float(w & 0xffff0000u); }
__device__ __forceinline__ float silu_f(float x) { return x * __builtin_amdgcn_rcpf(1.f + __expf(-x)); }
__device__ __forceinline__ float gelu_tanh(float x) { const float u = 0.7978845608028654f * (x + 0.044715f * x * x * x); const float e = __expf(-2.f * fabsf(u)); const float t = (1.f - e) * __builtin_amdgcn_rcpf(1.f + e); return 0.5f * x * (1.f + (u < 0.f ? -t : t)); }
__device__ __forceinline__ float softplus_f(float x) { return x > 20.f ? x : log1pf(__expf(x)); }
#define KSWZ(row, colB) ((row) * 256 + ((colB) ^ (((row) & 7) << 4)))
__device__ __forceinline__ void unpack8(const u32x4 w, float* f) { f[0] = bflo(w.x); f[1] = bfhi(w.x); f[2] = bflo(w.y); f[3] = bfhi(w.y); f[4] = bflo(w.z); f[5] = bfhi(w.z); f[6] = bflo(w.w); f[7] = bfhi(w.w); }
__device__ __forceinline__ u32x4 pack8(const float* f) { u32x4 w; w.x = cvt_pk_bf16(f[0], f[1]); w.y = cvt_pk_bf16(f[2], f[3]); w.z = cvt_pk_bf16(f[4], f[5]); w.w = cvt_pk_bf16(f[6], f[7]); return w; }

namespace pg8 {
constexpr int BM = 256, BK = 64, HALF = 128, HTB = HALF * BK * 2, STAGE_BYTES = 8 * HTB, NXCD = 8, WGM = 8;
__device__ __forceinline__ int lds_byte(int r, int c) { const int st = (r >> 4) * 2 + (c >> 5), rr = r & 15, cc = c & 31, ob = rr * 64 + cc * 2; return st * 1024 + (ob ^ (((ob >> 9) & 1) << 5)); }
__device__ __forceinline__ void stage_rc(int b, int& R, int& C) { const int st = b / 1024, sb = b % 1024, swz = sb ^ (((sb >> 9) & 1) << 5); R = (st >> 1) * 16 + swz / 64; C = (st & 1) * 32 + (swz % 64) / 2; }
__device__ __forceinline__ int perm32(int rho) { const int n = rho >> 4, i = rho & 15; return 8 * (i >> 2) + 4 * n + (i & 3); }

struct Unit { int pm, pn, orow, ocol, bat, s0, ni; };

enum { MAP_PLAIN = 0, MAP_LATENT = 1, MAP_DFT = 2, MAP_FSWAP = 3, MAP_RAW = 4 };
enum { EPI_BF16 = 0, EPI_BF16_DT = 1, EPI_RES = 2, EPI_UPF = 3 };
struct Desc {
    const bf16_t* A; const bf16_t* Bt; int K;
    int map, nM, nN, b0;
    int a_local;
    int o_local;
    int epi; int perm;
    void* O; int ldc;
    float* DT;
    const float* gate;
    const float* xin; const float* cin;
    const float* stats; const float* lng; const float* lnb;
    const float* cw; const float* cb; const bf16_t* pbnd;
};

__device__ __forceinline__ bool sched_next(const Desc& d, int i, int G, int c, Unit& u) {
    const int nM = d.nM, nN = d.nN, nwg = nM * nN;
    const long L = (long)i * G + c; if (L >= nwg) return false;
    int wgid = (int)L; { const int q = nwg / NXCD, r = nwg % NXCD, xcd = wgid % NXCD, off = wgid / NXCD; wgid = (xcd < r ? xcd * (q + 1) : r * (q + 1) + (xcd - r) * q) + off; }
    const int nig = WGM * nN, gid = wgid / nig, fm = gid * WGM, gsz = (nM - fm) < WGM ? (nM - fm) : WGM;
    const int mi = fm + ((wgid % nig) % gsz), ni = (wgid % nig) / gsz;
    u.ni = ni;
    if (d.map == MAP_PLAIN) {
        const int t = d.b0 * 9 + mi; u.bat = t / 9; u.s0 = (t % 9) * 256; u.pm = d.a_local ? mi : t; u.pn = ni; u.orow = (d.o_local ? mi : t) * 256; u.ocol = ni * 256;
    } else if (d.map == MAP_LATENT) {
        const int bl = mi >> 3, j = mi & 7, t = (d.b0 + bl) * 9 + 1 + j, tl = bl * 9 + 1 + j; u.bat = d.b0 + bl; u.s0 = 256 + j * 256; u.pm = d.a_local ? tl : t; u.pn = ni; u.orow = (d.o_local ? tl : t) * 256; u.ocol = ni * 256;
    } else if (d.map == MAP_DFT) {
        const int bl = mi >> 3, j = mi & 7; u.bat = bl; u.s0 = 256 + j * 256; u.pm = j; u.pn = bl * 2 + ni; u.orow = bl * SPB + 256 + j * 256; u.ocol = ni * 256;
    } else if (d.map == MAP_RAW) {
        u.bat = 0; u.s0 = 0; u.pm = mi; u.pn = ni; u.orow = mi * 256; u.ocol = ni * 256;
    } else {
        const int bl = ni >> 3, j = ni & 7; u.bat = bl; u.s0 = 0; u.pm = mi; u.pn = bl * 9 + 1 + j; u.orow = bl * 512 + (mi & 1) * 256; u.ocol = (mi >> 1) * 2048 + j * 256;
    }
    return true;
}

__device__ __forceinline__ void epilogue(const Desc& d, const f32x4 (&acc)[2][2][4][2], const Unit& u, int wr, int wc, int fr, int fq) {
    if (d.epi == EPI_RES) {
        bf16_t* XL = (bf16_t*)d.O;
        const int col0 = u.ocol + wc * 32 + 8 * fq;
        const float* gp = d.gate + (size_t)(u.s0 == 0 ? 32 : u.bat) * 6144 + col0;
        const float* fbase = nullptr; size_t brow0 = 0;
        if (d.xin) { if (u.s0 == 0) { fbase = d.cin; brow0 = (size_t)u.bat * CTXL; } else { fbase = d.xin; brow0 = (size_t)u.bat * SEQ + (u.s0 - 256); } }
#pragma unroll
        for (int bj = 0; bj < 2; ++bj) {
            const int co = bj * HALF;
            const f32x4 gv0 = *(const f32x4*)(gp + co), gv1 = *(const f32x4*)(gp + co + 4);
            f32x4 lg0 = {1.f, 1.f, 1.f, 1.f}, lg1 = lg0, lb0 = {0.f, 0.f, 0.f, 0.f}, lb1 = lb0;
            if (d.stats) { lg0 = *(const f32x4*)(d.lng + col0 + co); lg1 = *(const f32x4*)(d.lng + col0 + co + 4); lb0 = *(const f32x4*)(d.lnb + col0 + co); lb1 = *(const f32x4*)(d.lnb + col0 + co + 4); }
#define RES_FINISH(C0, C1, M_) do { f32x4 c0_ = (C0), c1_ = (C1); const int r_ = ai * HALF + wr * 64 + (M_) * 16 + fr; \
                    if (d.stats) { c0_ = (c0_ - st[M_][0]) * st[M_][1] * lg0 + lb0; c1_ = (c1_ - st[M_][0]) * st[M_][1] * lg1 + lb1; } \
                    const f32x4 o0_ = c0_ * DN_ALPHA + gv0 * acc[ai][bj][M_][0], o1_ = c1_ * DN_ALPHA + gv1 * acc[ai][bj][M_][1]; \
                    u32x4 w_; w_.x = cvt_pk_bf16(o0_[0], o0_[1]); w_.y = cvt_pk_bf16(o0_[2], o0_[3]); w_.z = cvt_pk_bf16(o1_[0], o1_[1]); w_.w = cvt_pk_bf16(o1_[2], o1_[3]); \
                    *(u32x4*)(XL + ((size_t)u.orow + r_) * 1024 + col0 + co) = w_; } while (0)
            if (fbase) {
#pragma unroll
                for (int ai = 0; ai < 2; ++ai) {
                    f32x4 b0[4], b1[4]; const f32x2 st[4] = {{0.f, 1.f}, {0.f, 1.f}, {0.f, 1.f}, {0.f, 1.f}};
#pragma unroll
                    for (int m = 0; m < 4; ++m) { const float* bp = fbase + (brow0 + ai * HALF + wr * 64 + m * 16 + fr) * 1024 + col0 + co; b0[m] = *(const f32x4*)(bp); b1[m] = *(const f32x4*)(bp + 4); }
#pragma unroll
                    for (int m = 0; m < 4; ++m) RES_FINISH(b0[m], b1[m], m);
                }
            } else {
#pragma unroll
                for (int ai = 0; ai < 2; ++ai) {
                    u32x4 bw[4]; f32x2 st[4];
#pragma unroll
                    for (int m = 0; m < 4; ++m) { const size_t rr = (size_t)u.orow + ai * HALF + wr * 64 + m * 16 + fr; bw[m] = *(const u32x4*)(XL + rr * 1024 + col0 + co); st[m] = d.stats ? *(const f32x2*)(d.stats + rr * 2) : (f32x2){0.f, 1.f}; }
#pragma unroll
                    for (int m = 0; m < 4; ++m) RES_FINISH(((f32x4){bflo(bw[m].x), bfhi(bw[m].x), bflo(bw[m].y), bfhi(bw[m].y)}), ((f32x4){bflo(bw[m].z), bfhi(bw[m].z), bflo(bw[m].w), bfhi(bw[m].w)}), m);
                }
            }
#undef RES_FINISH
        }
    } else {
        if (d.epi == EPI_BF16_DT && u.ni == 6) {
            if (wc == 0 && fq < 2) {
#pragma unroll
                for (int ai = 0; ai < 2; ++ai)
#pragma unroll
                    for (int m = 0; m < 4; ++m) { float* rowp = d.DT + ((size_t)u.orow + ai * HALF + wr * 64 + m * 16 + fr) * 16 + 8 * fq;
                        *(f32x4*)(rowp) = acc[ai][0][m][0]; *(f32x4*)(rowp + 4) = acc[ai][0][m][1]; }
            }
            return;
        }
        bf16_t* O = (bf16_t*)d.O; const int ldc = d.ldc;
        const int col0 = u.ocol + wc * 32 + 8 * fq;
#pragma unroll
        for (int ai = 0; ai < 2; ++ai)
#pragma unroll
            for (int m = 0; m < 4; ++m) { bf16_t* rowp = O + ((size_t)u.orow + ai * HALF + wr * 64 + m * 16 + fr) * ldc + col0;
#pragma unroll
                for (int bj = 0; bj < 2; ++bj) { const f32x4 v0 = acc[ai][bj][m][0], v1 = acc[ai][bj][m][1];
                    u32x4 w; w.x = cvt_pk_bf16(v0[0], v0[1]); w.y = cvt_pk_bf16(v0[2], v0[3]); w.z = cvt_pk_bf16(v1[0], v1[1]); w.w = cvt_pk_bf16(v1[2], v1[3]);
                    *(u32x4*)(rowp + bj * HALF) = w; } }
    }
}


__device__ __forceinline__ float dpp_shr1(float v) { return __int_as_float(__builtin_amdgcn_update_dpp(0, __float_as_int(v), 0x111, 0xf, 0xf, true)); }
__device__ __forceinline__ float dpp_shl1(float v) { return __int_as_float(__builtin_amdgcn_update_dpp(0, __float_as_int(v), 0x101, 0xf, 0xf, true)); }
__device__ __forceinline__ float dpp_mir(float v) { return __int_as_float(__builtin_amdgcn_update_dpp(0, __float_as_int(v), 0x140, 0xf, 0xf, true)); }
__device__ __forceinline__ void epilogue_upf(const Desc& d, const f32x4 (&acc)[2][2][4][2], const Unit& u, int wr, int wc, int fr, int fq, LAS unsigned char* lds) {
    LAS float* XB = (LAS float*)(lds + STAGE_BYTES);
    const int colb = 32 * wc + 8 * fq;
    f32x4 wa0[3], wg0[3], ba0, bg0;
    { const int j = u.ni * 128 + colb;
#pragma unroll
        for (int k = 0; k < 3; ++k) { wa0[k] = *(const f32x4*)(d.cw + k * DFF2 + j); wg0[k] = *(const f32x4*)(d.cw + k * DFF2 + DFF + j); }
        ba0 = *(const f32x4*)(d.cb + j); bg0 = *(const f32x4*)(d.cb + DFF + j); }
    const int jt = (u.s0 - 256) >> 8;
    const bool has_lo = u.s0 > 256, has_hi = (u.s0 >= 256) && (jt < 7);
    u32x2 hal[2][2] = {{{0u, 0u}, {0u, 0u}}, {{0u, 0u}, {0u, 0u}}};
    if (wr == 0 ? has_lo : has_hi) {
        const bf16_t* hp = d.pbnd + (size_t)(wr == 0 ? ((u.bat * 7 + jt - 1) * 2 + 0) : ((u.bat * 7 + jt) * 2 + 1)) * DFF2 + u.ocol + colb;
#pragma unroll
        for (int n = 0; n < 2; ++n) { hal[n][0] = *(const u32x2*)(hp + 4 * n); hal[n][1] = *(const u32x2*)(hp + 128 + 4 * n); }
    }
    if (fr == 0) {
#pragma unroll
        for (int ai = 0; ai < 2; ++ai)
#pragma unroll
            for (int bj = 0; bj < 2; ++bj)
#pragma unroll
                for (int n = 0; n < 2; ++n) *(LAS f32x4*)(XB + ((2 * ai + wr) * 2 + 0) * 256 + 128 * bj + colb + 4 * n) = acc[ai][bj][0][n];
    }
    if (fr == 15) {
#pragma unroll
        for (int ai = 0; ai < 2; ++ai)
#pragma unroll
            for (int bj = 0; bj < 2; ++bj)
#pragma unroll
                for (int n = 0; n < 2; ++n) *(LAS f32x4*)(XB + ((2 * ai + wr) * 2 + 1) * 256 + 128 * bj + colb + 4 * n) = acc[ai][bj][3][n];
    }
    asm volatile("s_waitcnt lgkmcnt(0)" ::: "memory"); __builtin_amdgcn_s_barrier(); asm volatile("" ::: "memory"); __builtin_amdgcn_s_barrier(); asm volatile("" ::: "memory");
    const float m0 = (fr == 0) ? 1.f : 0.f, m15 = (fr == 15) ? 1.f : 0.f;
    bf16_t* G = (bf16_t*)d.O;
#pragma unroll
    for (int n = 0; n < 2; ++n) {
        const int j = u.ni * 128 + colb + 4 * n;
        f32x4 wa[3], wg[3], ba, bg;
        if (n == 0) {
#pragma unroll
            for (int k = 0; k < 3; ++k) { wa[k] = wa0[k]; wg[k] = wg0[k]; }
            ba = ba0; bg = bg0;
        } else {
#pragma unroll
            for (int k = 0; k < 3; ++k) { wa[k] = *(const f32x4*)(d.cw + k * DFF2 + j); wg[k] = *(const f32x4*)(d.cw + k * DFF2 + DFF + j); }
            ba = *(const f32x4*)(d.cb + j); bg = *(const f32x4*)(d.cb + DFF + j);
        }
#pragma unroll
        for (int ai = 0; ai < 2; ++ai) {
            const int q = 2 * ai + wr;
            f32x4 pra, prg, sua, sug;
            if (q > 0) { pra = *(const LAS f32x4*)(XB + ((q - 1) * 2 + 1) * 256 + colb + 4 * n); prg = *(const LAS f32x4*)(XB + ((q - 1) * 2 + 1) * 256 + 128 + colb + 4 * n); }
            else { const u32x2 a_ = hal[n][0], g_ = hal[n][1]; pra = (f32x4){bflo(a_.x), bfhi(a_.x), bflo(a_.y), bfhi(a_.y)}; prg = (f32x4){bflo(g_.x), bfhi(g_.x), bflo(g_.y), bfhi(g_.y)}; }
            if (q < 3) { sua = *(const LAS f32x4*)(XB + ((q + 1) * 2 + 0) * 256 + colb + 4 * n); sug = *(const LAS f32x4*)(XB + ((q + 1) * 2 + 0) * 256 + 128 + colb + 4 * n); }
            else { const u32x2 a_ = hal[n][0], g_ = hal[n][1]; sua = (f32x4){bflo(a_.x), bfhi(a_.x), bflo(a_.y), bfhi(a_.y)}; sug = (f32x4){bflo(g_.x), bfhi(g_.x), bflo(g_.y), bfhi(g_.y)}; }
#pragma unroll
            for (int m = 0; m < 4; ++m) {
                const f32x4 va = acc[ai][0][m][n], vg = acc[ai][1][m][n];
                float o[4];
#pragma unroll
                for (int e = 0; e < 4; ++e) {
                    const float ea = (m > 0) ? dpp_mir(acc[ai][0][m > 0 ? m - 1 : 0][n][e]) : pra[e], eg = (m > 0) ? dpp_mir(acc[ai][1][m > 0 ? m - 1 : 0][n][e]) : prg[e];
                    const float fa = (m < 3) ? dpp_mir(acc[ai][0][m < 3 ? m + 1 : 3][n][e]) : sua[e], fg = (m < 3) ? dpp_mir(acc[ai][1][m < 3 ? m + 1 : 3][n][e]) : sug[e];
                    const float pa = fmaf(m0, ea, dpp_shr1(va[e])), pg = fmaf(m0, eg, dpp_shr1(vg[e]));
                    const float na = fmaf(m15, fa, dpp_shl1(va[e])), ng = fmaf(m15, fg, dpp_shl1(vg[e]));
                    const float a = ba[e] + wa[0][e] * pa + wa[1][e] * va[e] + wa[2][e] * na;
                    const float g = bg[e] + wg[0][e] * pg + wg[1][e] * vg[e] + wg[2][e] * ng;
                    o[e] = a * silu_f(g);
                }
                u32x2 w; w.x = cvt_pk_bf16(o[0], o[1]); w.y = cvt_pk_bf16(o[2], o[3]);
                *(u32x2*)(G + ((size_t)u.orow + ai * HALF + wr * 64 + m * 16 + fr) * DFF + j) = w;
                __builtin_amdgcn_sched_barrier(0);
            }
        }
    }
}

__device__ __forceinline__ void gemm_phase(LAS unsigned char* lds, const Desc& g, int G, int cidx, const int tid) {
    const int wid = __builtin_amdgcn_readfirstlane(tid >> 6), lane = tid & 63, wr = wid >> 2, wc = wid & 3, fr = lane & 15, fq = lane >> 4;
    const int K = g.K, nt = K / BK;
    unsigned voffA[2], voffB[2];
#pragma unroll
    for (int i = 0; i < 2; ++i) { int R, C; stage_rc(tid * 16 + i * 8192, R, C); const int Rb = g.perm ? ((R & ~31) + perm32(R & 31)) : R;
        voffA[i] = (unsigned)(R * K + C) * 2u; voffB[i] = (unsigned)(Rb * K + C) * 2u; }
    const size_t kstep = (size_t)(BK * 2);
    const size_t hstep = (size_t)HALF * K * 2;
    const size_t tstep = 2 * hstep;
    const unsigned ldsw = (unsigned)wid * 1024u;
    const int aoff = lds_byte(wr * 64 + fr, fq * 8), boff = lds_byte(wc * 32 + fr, fq * 8);
#define PG8_SA(b, h) (((b) * 2 + (h)) * HTB)
#define PG8_SB(b, h) ((4 + (b) * 2 + (h)) * HTB)
#define PG8_STAGE(bufoff, gbase, voff) do { _Pragma("unroll") for (int _i = 0; _i < 2; ++_i) \
        __builtin_amdgcn_global_load_lds((const unsigned*)((const char*)(gbase) + (voff)[_i]), (LAS unsigned*)(lds + (bufoff) + ldsw + _i * 8192), 16, 0, 0); } while (0)
#define PG8_LDA(dst, b, h) do { _Pragma("unroll") for (int m = 0; m < 4; ++m) _Pragma("unroll") for (int k = 0; k < 2; ++k) dst[m][k] = *(const LAS bf16x8*)(lds + PG8_SA(b, h) + aoff + m * 2048 + k * 1024); } while (0)
#define PG8_LDB(dst, b, h) do { _Pragma("unroll") for (int n = 0; n < 2; ++n) _Pragma("unroll") for (int k = 0; k < 2; ++k) dst[n][k] = *(const LAS bf16x8*)(lds + PG8_SB(b, h) + boff + n * 2048 + k * 1024); } while (0)
#define PG8_MMA(ai, bj, At, Bt) do { __builtin_amdgcn_s_setprio(1); _Pragma("unroll") for (int m = 0; m < 4; ++m) _Pragma("unroll") for (int n = 0; n < 2; ++n) _Pragma("unroll") for (int k = 0; k < 2; ++k) \
        acc[ai][bj][m][n] = __builtin_amdgcn_mfma_f32_16x16x32_bf16(Bt[n][k], At[m][k], acc[ai][bj][m][n], 0, 0, 0); __builtin_amdgcn_s_setprio(0); } while (0)
#define PG8_WAIT_V(n) asm volatile("s_waitcnt vmcnt(" #n ")" ::: "memory")
#define PG8_WAIT_L(n) asm volatile("s_waitcnt lgkmcnt(" #n ")" ::: "memory")
#define PG8_BAR __builtin_amdgcn_s_barrier()
#define PG8_SCHED __builtin_amdgcn_sched_barrier(0)
    Unit cur, nxt; int ui = 0;
    if (!sched_next(g, 0, G, cidx, cur)) return;
    f32x4 acc[2][2][4][2];
#pragma unroll
    for (int a = 0; a < 2; ++a)
#pragma unroll
        for (int b = 0; b < 2; ++b)
#pragma unroll
            for (int m = 0; m < 4; ++m)
#pragma unroll
                for (int n = 0; n < 2; ++n) acc[a][b][m][n] = (f32x4){0.f, 0.f, 0.f, 0.f};
    bf16x8 At[4][2], B0[2][2], B1[2][2];
    const char* cA = (const char*)g.A + (size_t)cur.pm * tstep; const char* cB = (const char*)g.Bt + (size_t)cur.pn * tstep;
    PG8_STAGE(PG8_SB(0, 0), cB, voffB); PG8_STAGE(PG8_SB(0, 1), cB + hstep, voffB); PG8_STAGE(PG8_SA(0, 0), cA, voffA); PG8_STAGE(PG8_SA(0, 1), cA + hstep, voffA);
    if (wr == 1) PG8_BAR;
    PG8_WAIT_V(2); PG8_BAR;
    PG8_STAGE(PG8_SB(1, 0), cB + kstep, voffB); PG8_STAGE(PG8_SA(1, 0), cA + kstep, voffA); PG8_STAGE(PG8_SB(1, 1), cB + hstep + kstep, voffB);
    PG8_WAIT_V(6); PG8_BAR;
    for (;;) {
        const bool has_next = sched_next(g, ui + 1, G, cidx, nxt);
        const char* nA = has_next ? (const char*)g.A + (size_t)nxt.pm * tstep : cA; const char* nB = has_next ? (const char*)g.Bt + (size_t)nxt.pn * tstep : cB;
        for (int t = 0; t < nt; t += 2) {
            const bool last = (t == nt - 2);
            const char* a1 = cA + (size_t)(t + 1) * kstep;
            const char* a2 = last ? nA : cA + (size_t)(t + 2) * kstep; const char* b2 = last ? nB : cB + (size_t)(t + 2) * kstep;
            const char* a3 = a2 + kstep; const char* b3 = b2 + kstep;
            PG8_LDB(B0, 0, 0); PG8_LDB(B1, 0, 1); PG8_SCHED; PG8_LDA(At, 0, 0); PG8_STAGE(PG8_SA(1, 1), a1 + hstep, voffA);
            PG8_WAIT_V(8); PG8_WAIT_L(0); PG8_BAR; PG8_MMA(0, 0, At, B0); PG8_MMA(0, 1, At, B1); PG8_BAR; PG8_SCHED;
            PG8_LDA(At, 0, 1); PG8_STAGE(PG8_SB(0, 0), b2, voffB); PG8_STAGE(PG8_SB(0, 1), b2 + hstep, voffB); PG8_STAGE(PG8_SA(0, 0), a2, voffA);
            PG8_WAIT_V(8); PG8_WAIT_L(0); PG8_BAR; PG8_MMA(1, 0, At, B0); PG8_MMA(1, 1, At, B1); PG8_BAR; PG8_SCHED;
            PG8_LDB(B0, 1, 0); PG8_LDB(B1, 1, 1); PG8_SCHED; PG8_LDA(At, 1, 0); PG8_STAGE(PG8_SA(0, 1), a2 + hstep, voffA);
            PG8_WAIT_V(8); PG8_WAIT_L(0); PG8_BAR; PG8_MMA(0, 0, At, B0); PG8_MMA(0, 1, At, B1); PG8_BAR; PG8_SCHED;
            PG8_LDA(At, 1, 1); PG8_STAGE(PG8_SB(1, 0), b3, voffB); PG8_STAGE(PG8_SB(1, 1), b3 + hstep, voffB); PG8_STAGE(PG8_SA(1, 0), a3, voffA);
            PG8_WAIT_V(8); PG8_WAIT_L(0); PG8_BAR; PG8_MMA(1, 0, At, B0); PG8_MMA(1, 1, At, B1); PG8_BAR; PG8_SCHED;
        }
        if (wr == 0) PG8_BAR;
        { int lane2 = lane; asm volatile("" : "+v"(lane2)); if (g.epi == EPI_UPF) epilogue_upf(g, acc, cur, wr, wc, lane2 & 15, lane2 >> 4, lds); else epilogue(g, acc, cur, wr, wc, lane2 & 15, lane2 >> 4); }
        if (!has_next) break;
#pragma unroll
        for (int a = 0; a < 2; ++a)
#pragma unroll
            for (int b = 0; b < 2; ++b)
#pragma unroll
                for (int m = 0; m < 4; ++m)
#pragma unroll
                    for (int n = 0; n < 2; ++n) acc[a][b][m][n] = (f32x4){0.f, 0.f, 0.f, 0.f};
        cur = nxt; cA = nA; cB = nB; ++ui;
        if (wr == 1) PG8_BAR;
    }
    PG8_WAIT_V(0);
    PG8_BAR;
#undef PG8_SA
#undef PG8_SB
#undef PG8_STAGE
#undef PG8_LDA
#undef PG8_LDB
#undef PG8_MMA
#undef PG8_WAIT_V
#undef PG8_WAIT_L
#undef PG8_BAR
#undef PG8_SCHED
}
}

namespace att {
constexpr int D = 128, NW = 8, QBLK = 32, KVBLK = 64;
constexpr float SCALE = 0.088388347648318440f;
constexpr float THR = 8.f;
constexpr int LDQ = 2048, LDK = 2048, LDO = 1024;
constexpr size_t SHM_V = KVBLK * D * 2, SHM_K = KVBLK * D * 2, SHM_ATTN = 2 * SHM_V + 2 * SHM_K + NW * 64 * 4;
#define SBAR() __builtin_amdgcn_sched_barrier(0)
__device__ __forceinline__ int crow(int r, int hi) { return (r & 3) + 8 * (r >> 2) + 4 * hi; }
__device__ __forceinline__ void partialSM(f32x16& p0, f32x16& p1, float& m_reg, float& mn, float& alpha) {
  constexpr float C = SCALE * 1.4426950408889634f;
  float pmax = p0[0]; for (int r = 1; r < 16; ++r) pmax = fmaxf(pmax, p0[r]); for (int r = 0; r < 16; ++r) pmax = fmaxf(pmax, p1[r]);
  { auto rr = __builtin_amdgcn_permlane32_swap(__float_as_uint(pmax), __float_as_uint(pmax), false, false);
    pmax = fmaxf(__uint_as_float(rr[0]), __uint_as_float(rr[1])); }
  if (__builtin_expect(__all(pmax - m_reg <= THR / SCALE), 1)) { mn = m_reg; alpha = 1.f; }
  else { mn = fmaxf(m_reg, pmax); alpha = __builtin_amdgcn_exp2f((m_reg - mn) * C); m_reg = mn; }
  float mnC = -mn * C;
  for (int r = 0; r < 16; ++r) p0[r] = fmaf(p0[r], C, mnC); for (int r = 0; r < 16; ++r) p1[r] = fmaf(p1[r], C, mnC);
  for (int r = 0; r < 16; ++r) p0[r] = __builtin_amdgcn_exp2f(p0[r]);
}
__device__ __forceinline__ void finishSM(f32x16& p0, f32x16& p1, float alpha, float& l_reg, bf16x8& pa0, bf16x8& pa1, bf16x8& pa2, bf16x8& pa3) {
  for (int r = 0; r < 16; ++r) p1[r] = __builtin_amdgcn_exp2f(p1[r]);
  float ps = 0; for (int r = 0; r < 16; ++r) ps += p0[r]; for (int r = 0; r < 16; ++r) ps += p1[r];
  { auto rr = __builtin_amdgcn_permlane32_swap(__float_as_uint(ps), __float_as_uint(ps), false, false);
    ps = __uint_as_float(rr[0]) + __uint_as_float(rr[1]); }
  l_reg = l_reg * alpha + ps;
#define PK4(P, BASE, OUT) do { unsigned a0 = cvt_pk_bf16_asm(P[BASE + 0], P[BASE + 1]), a1 = cvt_pk_bf16_asm(P[BASE + 2], P[BASE + 3]);   \
    unsigned b0 = cvt_pk_bf16_asm(P[BASE + 4], P[BASE + 5]), b1 = cvt_pk_bf16_asm(P[BASE + 6], P[BASE + 7]);                              \
    auto r0 = __builtin_amdgcn_permlane32_swap(a0, b0, false, false); auto r1 = __builtin_amdgcn_permlane32_swap(a1, b1, false, false); \
    u32x4 w = {r0[0], r1[0], r0[1], r1[1]}; OUT = *reinterpret_cast<bf16x8*>(&w); } while (0)
  PK4(p0, 0, pa0); PK4(p0, 8, pa1); PK4(p1, 0, pa2); PK4(p1, 8, pa3);
#undef PK4
}
__device__ __forceinline__ void qkt(f32x16& p0, f32x16& p1, const bf16_t* Ks, const bf16x8* qr, int r32, int hi) {
  p0 = f32x16{}; p1 = f32x16{};
  for (int d0 = 0; d0 < 8; ++d0) { int cb = (d0 * 16 + hi * 8) * 2;
    bf16x8 b0 = *reinterpret_cast<const bf16x8*>((const char*)Ks + KSWZ(r32, cb));
    bf16x8 b1 = *reinterpret_cast<const bf16x8*>((const char*)Ks + KSWZ(32 + r32, cb));
    p0 = __builtin_amdgcn_mfma_f32_32x32x16_bf16(b0, qr[d0], p0, 0, 0, 0);
    p1 = __builtin_amdgcn_mfma_f32_32x32x16_bf16(b1, qr[d0], p1, 0, 0, 0); }
}
__device__ __forceinline__ int v_st(int k, int c) { const int kk = (k & ~0xC) | ((k & 4) << 1) | ((k & 8) >> 1); return ((kk >> 3) * 4 + (c >> 5)) * 512 + ((kk & 7) * 32 + (c & 31)) * 2; }
__device__ __forceinline__ int v_rd_base(int lane) { return ((lane & 3) << 3) | (((lane >> 2) & 3) << 6) | (((lane >> 4) & 1) << 5) | (((lane >> 5) & 1) << 8); }
constexpr int v_rd_off(int d0, int ks, int half) { return d0 * 512 + ks * 4096 + half * 2048; }
template <int OFF> __device__ __forceinline__ s16x4 tr_read(int vb) {
  s16x4 r; asm volatile("ds_read_b64_tr_b16 %0, %1 offset:%2" : "=&v"(r) : "v"(vb), "i"(OFF) : "memory"); return r;
}
template <int D0> __device__ __forceinline__ void pv_one(f32x16& od, int vb, bf16x8 pa0, bf16x8 pa1, bf16x8 pa2, bf16x8 pa3) {
  const s16x4 l0 = tr_read<v_rd_off(D0, 0, 0)>(vb), h0 = tr_read<v_rd_off(D0, 0, 1)>(vb), l1 = tr_read<v_rd_off(D0, 1, 0)>(vb), h1 = tr_read<v_rd_off(D0, 1, 1)>(vb);
  const s16x4 l2 = tr_read<v_rd_off(D0, 2, 0)>(vb), h2 = tr_read<v_rd_off(D0, 2, 1)>(vb), l3 = tr_read<v_rd_off(D0, 3, 0)>(vb), h3 = tr_read<v_rd_off(D0, 3, 1)>(vb);
  asm volatile("s_waitcnt lgkmcnt(0)" ::: "memory"); SBAR();
#define PK(L, H) (bf16x8){L[0], L[1], L[2], L[3], H[0], H[1], H[2], H[3]}
  od = __builtin_amdgcn_mfma_f32_32x32x16_bf16(pa0, PK(l0, h0), od, 0, 0, 0);
  od = __builtin_amdgcn_mfma_f32_32x32x16_bf16(pa1, PK(l1, h1), od, 0, 0, 0);
  od = __builtin_amdgcn_mfma_f32_32x32x16_bf16(pa2, PK(l2, h2), od, 0, 0, 0);
  od = __builtin_amdgcn_mfma_f32_32x32x16_bf16(pa3, PK(l3, h3), od, 0, 0, 0);
#undef PK
}
__device__ __forceinline__ void pv_d0(f32x16* o, int vb, bf16x8 pa0, bf16x8 pa1, bf16x8 pa2, bf16x8 pa3) {
  pv_one<0>(o[0], vb, pa0, pa1, pa2, pa3); pv_one<1>(o[1], vb, pa0, pa1, pa2, pa3); pv_one<2>(o[2], vb, pa0, pa1, pa2, pa3); pv_one<3>(o[3], vb, pa0, pa1, pa2, pa3);
}
__device__ __forceinline__ void attn_dense_body(const bf16_t* __restrict__ Qb, const bf16_t* __restrict__ Kh, const bf16_t* __restrict__ Vh, bf16_t* __restrict__ Ob, int seq, char* lds, const int tid) {
  const int wid = tid >> 6, lane = tid & 63, r32 = lane & 31, hi = lane >> 5;
  bf16_t* V_lds = (bf16_t*)lds; bf16_t* K_lds = (bf16_t*)(lds + 2 * SHM_V);
  float* ws = (float*)(lds + 2 * SHM_V + 2 * SHM_K) + wid * 64; float* li_l = ws; float* al_l = ws + 32;
  float m_reg = -1e30f, l_reg = 0; f32x16 o[4] = {}; bf16x8 qr[8];
  const bf16_t* Qw = Qb + (long)(wid * QBLK + r32) * LDQ + hi * 8;
#pragma unroll
  for (int d0 = 0; d0 < 8; ++d0) qr[d0] = *reinterpret_cast<const bf16x8*>(Qw + d0 * 16);
  const int sr = tid >> 4, sc = (tid & 15) * 8, vst0 = v_st(sr, sc), vst1 = v_st(32 + sr, sc);
  const int vb0 = (int)(uintptr_t)V_lds + v_rd_base(lane);
  struct { bf16x8 vs0, vs1, ks0, ks1; } sr_[2];
  const unsigned go0 = (unsigned)(sr * LDK + sc) * 2u, go1 = go0 + 32u * LDK * 2u;
#define SLOAD(i, k0) do { const char* vb_ = (const char*)Vh + (size_t)(k0) * (LDK * 2); const char* kb_ = (const char*)Kh + (size_t)(k0) * (LDK * 2); \
    sr_[i].vs0 = *reinterpret_cast<const bf16x8*>(vb_ + go0); sr_[i].vs1 = *reinterpret_cast<const bf16x8*>(vb_ + go1); \
    sr_[i].ks0 = *reinterpret_cast<const bf16x8*>(kb_ + go0); sr_[i].ks1 = *reinterpret_cast<const bf16x8*>(kb_ + go1); } while (0)
#define SWRITE(b, i) do { *(bf16x8*)((char*)V_lds + (b) * SHM_V + vst0) = sr_[i].vs0;          \
    *(bf16x8*)((char*)V_lds + (b) * SHM_V + vst1) = sr_[i].vs1; int kc = sc * 2;               \
    *(bf16x8*)((char*)K_lds + (b) * SHM_K + KSWZ(sr, kc)) = sr_[i].ks0;                       \
    *(bf16x8*)((char*)K_lds + (b) * SHM_K + KSWZ(32 + sr, kc)) = sr_[i].ks1; } while (0)
#define SWAIT() asm volatile("s_waitcnt vmcnt(4)" ::: "memory")
#define RESC(a) do { if (__any((a) < 1.f)) { if (hi == 0) al_l[r32] = (a); asm volatile("s_waitcnt lgkmcnt(0)" ::: "memory"); \
    for (int d = 0; d < 4; ++d) for (int r = 0; r < 16; ++r) o[d][r] *= al_l[crow(r, hi)]; } } while (0)
  f32x16 pA0, pA1, pB0, pB1; float mnA, mnB, alA, alB; bf16x8 pa0, pa1, pa2, pa3; const int NTL = seq / KVBLK;
  constexpr int SE = 0, SO = 1;
  SLOAD(SE, 0); asm volatile("s_waitcnt vmcnt(0)" ::: "memory"); SWRITE(0, SE); __syncthreads();
  qkt(pA0, pA1, K_lds, qr, r32, hi); partialSM(pA0, pA1, m_reg, mnA, alA);
  SLOAD(SO, KVBLK); if (2 < NTL) SLOAD(SE, 2 * KVBLK);
  SWAIT(); SWRITE(1, SO); __syncthreads();
  for (int j = 1; j + 1 < NTL; j += 2) {
    SBAR(); qkt(pB0, pB1, (bf16_t*)((char*)K_lds + SHM_K), qr, r32, hi);
    finishSM(pA0, pA1, alA, l_reg, pa0, pa1, pa2, pa3); SBAR();
    SLOAD(SO, (j + 2) * KVBLK); SBAR();
    pv_d0(o, vb0, pa0, pa1, pa2, pa3); partialSM(pB0, pB1, m_reg, mnB, alB);
    __syncthreads(); SWAIT(); SWRITE(0, SE);
    RESC(alB); __syncthreads();
    SBAR(); qkt(pA0, pA1, K_lds, qr, r32, hi);
    finishSM(pB0, pB1, alB, l_reg, pa0, pa1, pa2, pa3); SBAR();
    if (j + 3 < NTL) SLOAD(SE, (j + 3) * KVBLK); SBAR();
    pv_d0(o, vb0 + (int)SHM_V, pa0, pa1, pa2, pa3); partialSM(pA0, pA1, m_reg, mnA, alA);
    __syncthreads(); SWAIT(); SWRITE(1, SO);
    RESC(alA); __syncthreads();
  }
  SBAR(); qkt(pB0, pB1, (bf16_t*)((char*)K_lds + SHM_K), qr, r32, hi);
  finishSM(pA0, pA1, alA, l_reg, pa0, pa1, pa2, pa3); SBAR();
  pv_d0(o, vb0, pa0, pa1, pa2, pa3); partialSM(pB0, pB1, m_reg, mnB, alB);
  __syncthreads(); RESC(alB);
  finishSM(pB0, pB1, alB, l_reg, pa0, pa1, pa2, pa3); SBAR();
  pv_d0(o, vb0 + (int)SHM_V, pa0, pa1, pa2, pa3);
  if (hi == 0) li_l[r32] = l_reg; asm volatile("s_waitcnt lgkmcnt(0)" ::: "memory");
  int lane2 = lane; asm volatile("" : "+v"(lane2)); const int r32e = lane2 & 31, hie = lane2 >> 5;
  float rli[16];
#pragma unroll
  for (int r = 0; r < 16; ++r) rli[r] = __builtin_amdgcn_rcpf(li_l[crow(r, hie)]);
  bf16_t* Ow = Ob + (long)(wid * QBLK) * LDO + r32e;
#pragma unroll
  for (int r = 0; r < 16; ++r) { int orow = crow(r, hie);
#pragma unroll
    for (int d0 = 0; d0 < 4; ++d0) Ow[orow * LDO + d0 * 32] = (bf16_t)(cvt_pk_bf16_asm(o[d0][r] * rli[r], 0.f) & 0xffffu); }
#undef SLOAD
#undef SWRITE
#undef SWAIT
#undef RESC
}
}

struct Frame {
    const float* const* in; float* out; unsigned char* ws; unsigned char* lds; int tid, lane, wid, G, bx, wid0;
};
#define WSP(T, off) ((T*)(F.ws + (off)))
__device__ __forceinline__ void frame_refresh(Frame& F, const float* const* inb, unsigned char* wsb, float* outb, unsigned char* ldsb) {
    unsigned zero; asm volatile("s_mov_b32 %0, 0" : "=s"(zero));
    int lane_; asm volatile("v_mbcnt_lo_u32_b32 %0, -1, 0\n\tv_mbcnt_hi_u32_b32 %0, -1, %0" : "=v"(lane_));
    const int tid = (int)((unsigned)F.wid0 + zero) * 64 + lane_;
    F.in = inb + zero; F.ws = wsb + zero; F.out = outb + zero; F.lds = ldsb; F.bx = (int)(blockIdx.x + zero); F.G = (int)(gridDim.x + zero); F.tid = tid; F.lane = tid & 63; F.wid = __builtin_amdgcn_readfirstlane(tid >> 6);
}

__device__ __forceinline__ void cvt_tile(const Frame& F, const float* src, int ldw, int n0, int nvalid, int K, bf16_t* dst, int tn, int tk, int srccol) {
    float* T = (float*)F.lds;
    __syncthreads();
#pragma unroll
    for (int i = 0; i < 8; ++i) { const int kk = (F.tid >> 6) + 8 * i, nn = F.tid & 63; const int n = tn * 64 + nn;
        T[kk * 65 + nn] = (n < nvalid) ? src[(size_t)(tk * 64 + kk) * ldw + (srccol >= 0 ? srccol + nn : n0 + n)] : 0.f; }
    __syncthreads();
    const int nn = F.tid >> 3, ks = (F.tid & 7) * 8; float v[8];
#pragma unroll
    for (int e = 0; e < 8; ++e) v[e] = T[(ks + e) * 65 + nn];
    *(u32x4*)(dst + (size_t)(tn * 64 + nn) * K + tk * 64 + ks) = pack8(v);
}
__device__ __forceinline__ void phase_prep(const Frame& F) {
    {
        const int cnt[8] = {512, 256, 1408, 1408, 704, 704, 448, 256};
        int total = 0;
#pragma unroll
        for (int j = 0; j < 8; ++j) total += cnt[j];
        for (int t = F.bx; t < total; t += F.G) {
            int j = 0, loc = t;
#pragma unroll
            for (int q = 0; q < 8; ++q) { if (j == q && loc >= cnt[q]) { loc -= cnt[q]; j = q + 1; } }
            const float* src; int ldw, n0, nvalid, K; size_t dsto;
            switch (j) {
                case 0: src = F.in[14]; ldw = 2048; n0 = 0; nvalid = 2048; K = 1024; dsto = WS_W0IN; break;
                case 1: src = F.in[15]; ldw = 1024; n0 = 0; nvalid = 1024; K = 1024; dsto = WS_W0OUT; break;
                case 2: src = F.in[10]; ldw = DFF2; n0 = 0; nvalid = DFF2; K = 1024; dsto = WS_WUP0; break;
                case 3: src = F.in[10] + (size_t)1024 * DFF2; ldw = DFF2; n0 = 0; nvalid = DFF2; K = 1024; dsto = WS_WUP1; break;
                case 4: src = F.in[13]; ldw = 1024; n0 = 0; nvalid = 1024; K = DFF; dsto = WS_WDN0; break;
                case 5: src = F.in[13] + (size_t)DFF * 1024; ldw = 1024; n0 = 0; nvalid = 1024; K = DFF; dsto = WS_WDN1; break;
                case 6: src = F.in[22]; ldw = 2064; n0 = 512; nvalid = 1552; K = 1024; dsto = WS_W1IN; break;
                default: src = F.in[23]; ldw = 1024; n0 = 0; nvalid = 1024; K = 1024; dsto = WS_W1OUT; break;
            }
            const int nk = K / 64; const int tn = loc / nk, tk = loc % nk;
            const int srccol = (j == 2 || j == 3) ? (((tn >> 1) & 1) * DFF + (tn >> 2) * 128 + (tn & 1) * 64) : -1;
            cvt_tile(F, src, ldw, n0, nvalid, K, WSP(bf16_t, dsto), tn, tk, srccol);
        }
    }
    {
        float* Wt = (float*)F.lds;
        float* ctab = Wt + 64 * 129;
        bf16_t* W1F = WSP(bf16_t, WS_W1F);
        for (int job = F.bx; job < 64; job += F.G) {
            const int g = job >> 4, kt = job & 15;
            __syncthreads();
            if (F.tid < 128) ctab[F.tid] = cospif((float)F.tid / 64.f);
            for (int i = F.tid; i < 64 * 128; i += NT) { const int kk = i >> 7, d = i & 127; Wt[kk * 129 + d] = F.in[22][(size_t)(kt * 64 + kk) * 2064 + g * 128 + d]; }
            __syncthreads();
            const int o = F.tid >> 1, kh = (F.tid & 1) * 32;
            const int half = o >> 7, dp = o & 127;
            float accv[32];
#pragma unroll
            for (int e = 0; e < 32; ++e) accv[e] = 0.f;
            for (int d = 0; d < 128; ++d) {
                const int m = (d * dp) & 127; const float cs = ctab[half ? ((m - 32) & 127) : m];
#pragma unroll
                for (int e = 0; e < 32; ++e) accv[e] += cs * Wt[(kh + e) * 129 + d];
            }
            bf16_t* dst = W1F + (size_t)(half * 512 + g * 128 + dp) * 1024 + kt * 64 + kh;
#pragma unroll
            for (int e = 0; e < 32; e += 8) *(u32x4*)(dst + e) = pack8(accv + e);
        }
        __syncthreads();
    }
    {
        bf16_t* Dm = WSP(bf16_t, WS_DFT);
        for (size_t i = (size_t)F.bx * NT + F.tid; i < (size_t)2048 * 512; i += (size_t)F.G * NT) {
            const int lp = (int)(i >> 9), c8 = (int)(i & 511) * 8; float v[8];
#pragma unroll
            for (int e = 0; e < 8; ++e) { const int cidx = c8 + e; const int l = cidx & 2047; const int m = (l * lp) & 2047; const float a = (float)m / 1024.f;
                v[e] = (cidx < 2048 ? cospif(a) : -sinpif(a)) * (1.f / 512.f); }
            *(u32x4*)(Dm + (size_t)lp * 4096 + c8) = pack8(v);
        }
    }
    {
        f32x2* Rt = WSP(f32x2, WS_ROPE);
        for (int i = F.bx * NT + F.tid; i < 64 * 32; i += F.G * NT) { const int pos = i >> 5, f = i & 31; const float inv = expf(-(float)f * (9.210340371976184f / 32.f)); float sn, cs; sincosf((float)pos * inv, &sn, &cs); Rt[i] = (f32x2){cs, sn}; }
    }
    {
        bf16_t* Gw = WSP(bf16_t, WS_GWS);
        for (int i = F.bx * NT + F.tid; i < 65536 / 8; i += F.G * NT) { float v[8];
#pragma unroll
            for (int e = 0; e < 8; ++e) v[e] = F.in[18][i * 8 + e];
            *(u32x4*)(Gw + i * 8) = pack8(v); }
    }
    {
        float* cs = (float*)F.lds;
        float* red = cs + 33 * 256;
        float* MODP = WSP(float, WS_MODP);
        for (int job = F.G - 1 - F.bx; job < 384; job += F.G) {
            const int kq = job & 3, ntile = (job >> 2) % 48, layer = job / 192;
            __syncthreads();
            for (int i = F.tid; i < 33 * 256; i += NT) { const int j = i >> 8, kk = i & 255; const float cv = (j < 32) ? F.in[1][j * 1024 + kq * 256 + kk] : F.in[3][kq * 256 + kk]; cs[i] = silu_f(cv); }
            __syncthreads();
            const int nn = F.tid & 127, ks = F.tid >> 7;
            float a[33];
#pragma unroll
            for (int j = 0; j < 33; ++j) a[j] = 0.f;
            const float* wp = F.in[4] + ((size_t)layer * 1024 + kq * 256 + ks * 64) * 6144 + ntile * 128 + nn;
            for (int kk = 0; kk < 64; kk += 4) {
                const float w0 = wp[(size_t)(kk + 0) * 6144], w1 = wp[(size_t)(kk + 1) * 6144], w2 = wp[(size_t)(kk + 2) * 6144], w3 = wp[(size_t)(kk + 3) * 6144];
#pragma unroll
                for (int j = 0; j < 33; ++j) { const f32x4 c4 = *(const f32x4*)(cs + j * 256 + ks * 64 + kk); a[j] += w0 * c4[0] + w1 * c4[1] + w2 * c4[2] + w3 * c4[3]; }
            }
#pragma unroll
            for (int j = 0; j < 33; ++j) red[(ks * 33 + j) * 128 + nn] = a[j];
            __syncthreads();
            for (int i = F.tid; i < 33 * 128; i += NT) { const int j = i >> 7, n = i & 127;
                MODP[((size_t)(kq * 2 + layer) * 33 + j) * 6144 + ntile * 128 + n] = red[(0 * 33 + j) * 128 + n] + red[(1 * 33 + j) * 128 + n] + red[(2 * 33 + j) * 128 + n] + red[(3 * 33 + j) * 128 + n]; }
        }
        __syncthreads();
    }
}

__device__ __forceinline__ void phase_mod0(const Frame& F) {
    const float* MODP = WSP(float, WS_MODP); float* MOD = WSP(float, WS_MOD);
    for (int i = F.bx * NT + F.tid; i < 2 * 33 * 6144; i += F.G * NT) {
        const int layer = i / (33 * 6144), n = i % 6144;
        MOD[i] = F.in[5][layer * 6144 + n] + MODP[i] + MODP[(size_t)2 * 33 * 6144 + i] + MODP[(size_t)4 * 33 * 6144 + i] + MODP[(size_t)6 * 33 * 6144 + i];
    }
    bf16_t* H = WSP(bf16_t, WS_HA);
    const int gw = F.bx * 8 + F.wid, nw = F.G * 8;
    const int per = (NROWS + nw - 1) / nw;
    int curj = -1; f32x4 sh[4], sc[4];
    for (int r = gw * per; r < (gw + 1) * per && r < NROWS; r += 4) {
        const int b = r / SPB, s = r % SPB; const int j = s < 256 ? 32 : b;
        if (j != curj) { curj = j;
#pragma unroll
            for (int i = 0; i < 4; ++i) { const int c = F.lane * 4 + 256 * i; f32x4 a = *(const f32x4*)(F.in[5] + c), bq = *(const f32x4*)(F.in[5] + 1024 + c);
#pragma unroll
                for (int q = 0; q < 4; ++q) { a += *(const f32x4*)(MODP + ((size_t)(q * 2) * 33 + j) * 6144 + c); bq += *(const f32x4*)(MODP + ((size_t)(q * 2) * 33 + j) * 6144 + 1024 + c); }
                sh[i] = a; sc[i] = bq; } }
        f32x4 x[4][4];
#pragma unroll
        for (int q = 0; q < 4; ++q) { const int sq = s + q; const float* src = sq < 256 ? F.in[2] + ((size_t)b * CTXL + sq) * 1024 : F.in[0] + ((size_t)b * SEQ + sq - 256) * 1024;
#pragma unroll
            for (int i = 0; i < 4; ++i) x[q][i] = *(const f32x4*)(src + F.lane * 4 + 256 * i); }
#pragma unroll
        for (int q = 0; q < 4; ++q)
#pragma unroll
            for (int i = 0; i < 4; ++i) { const int c = F.lane * 4 + 256 * i; const f32x4 h = x[q][i] * (sc[i] + 1.f) + sh[i];
                u32x2 w; w.x = cvt_pk_bf16(h[0], h[1]); w.y = cvt_pk_bf16(h[2], h[3]); *(u32x2*)(H + (size_t)(r + q) * 1024 + c) = w; }
    }
}

__device__ __forceinline__ void phase_post0(const Frame& F) {
    bf16_t* PB = WSP(bf16_t, WS_R + R_PB);
    const int gw = F.bx * 8 + F.wid, nw = F.G * 8; const int per = (NROWS + nw - 1) / nw;
    const int l = F.lane;
    float ga[8], gb[8];
#pragma unroll
    for (int e = 0; e < 8; ++e) { ga[e] = F.in[16][l * 8 + e]; gb[e] = F.in[17][l * 8 + e]; }
    const int j = l & 7; const bool isq = l < 32;
    float gn[16];
#pragma unroll
    for (int e = 0; e < 16; ++e) gn[e] = (isq ? F.in[20] : F.in[21])[(16 * j + e) & 127];
    const int ax = j >> 2, hh = (j >> 1) & 1, f0 = (j & 1) * 16; const float sg = hh ? 1.f : -1.f;
    for (int r = gw * per; r < (gw + 1) * per && r < NROWS; ++r) {
        const int s = r % SPB;
        bf16_t* pa = PB + (size_t)r * 2048 + 512 + l * 8; bf16_t* pq = PB + (size_t)r * 2048 + 1024 + l * 16;
        const u32x4 ra = *(const u32x4*)pa; u32x4 rq0 = {0u, 0u, 0u, 0u}, rq1 = rq0;
        if (l < 48) { rq0 = *(const u32x4*)pq; rq1 = *(const u32x4*)(pq + 8); }
        {
            float v[8]; unpack8(ra, v); float sum = 0.f;
#pragma unroll
            for (int e = 0; e < 8; ++e) { v[e] = gelu_tanh(v[e]); sum += v[e]; }
#pragma unroll
            for (int o = 1; o < 64; o <<= 1) sum += __shfl_xor(sum, o);
            const float mu = sum * (1.f / 512.f); float q = 0.f;
#pragma unroll
            for (int e = 0; e < 8; ++e) { const float d = v[e] - mu; q += d * d; }
#pragma unroll
            for (int o = 1; o < 64; o <<= 1) q += __shfl_xor(q, o);
            const float rstd = rsqrtf(q * (1.f / 512.f) + EPSN);
#pragma unroll
            for (int e = 0; e < 8; ++e) v[e] = (v[e] - mu) * rstd * ga[e] + gb[e];
            *(u32x4*)pa = pack8(v);
        }
        if (l < 48) {
            float v[16]; unpack8(rq0, v); unpack8(rq1, v + 8); float ss = 0.f;
#pragma unroll
            for (int e = 0; e < 16; ++e) ss += v[e] * v[e];
            ss += __shfl_xor(ss, 1); ss += __shfl_xor(ss, 2); ss += __shfl_xor(ss, 4);
            const float rstd = rsqrtf(ss * (1.f / 128.f) + EPSN);
#pragma unroll
            for (int e = 0; e < 16; ++e) v[e] = v[e] * rstd * gn[e];
            const bool lat = s >= 256; const int t = s - 256;
            const int pos = lat ? (ax ? (t & 63) : (t >> 6)) : 0;
            const f32x4* rt = (const f32x4*)(WSP(const f32x2, WS_ROPE) + pos * 32 + f0);
#pragma unroll
            for (int e = 0; e < 16; e += 2) {
                const float o0 = __shfl_xor(v[e], 2), o1 = __shfl_xor(v[e + 1], 2);
                const f32x4 cs = rt[e >> 1];
                if (lat) { v[e] = v[e] * cs[0] + sg * o0 * cs[1]; v[e + 1] = v[e + 1] * cs[2] + sg * o1 * cs[3]; }
            }
            *(u32x4*)pq = pack8(v); *(u32x4*)(pq + 8) = pack8(v + 8);
        }
    }
}

__device__ __forceinline__ void phase_attn_gmlp(Frame& F) {
    const bf16_t* PB = WSP(bf16_t, WS_R + R_PB); bf16_t* AO = WSP(bf16_t, WS_HA);
#ifndef NO_ATTN
    for (int i = 0; ; ++i) {
        const int L = i * F.G + F.bx; if (L >= 1152) break;
        int b, h, qb, seq;
        if (L < 1024) { const int x = F.bx & 7, k = F.bx >> 3; b = (L / 256) * 8 + x; h = k >> 3; qb = 1 + (k & 7); seq = SPB; if (F.G != 256) { b = L >> 5; h = (L >> 3) & 3; qb = 1 + (L & 7); } }
        else { const int c = L - 1024; b = c >> 2; h = c & 3; qb = 0; seq = CTXL; }
        const size_t row0 = (size_t)b * SPB + qb * 256;
        __syncthreads();
        int t2 = F.tid; asm volatile("" : "+v"(t2));
        att::attn_dense_body(PB + row0 * 2048 + 1024 + h * 128, PB + (size_t)b * SPB * 2048 + 1536 + (h >> 1) * 128, PB + (size_t)b * SPB * 2048 + 1792 + (h >> 1) * 128,
                             AO + row0 * 1024 + 512 + h * 128, seq, (char*)F.lds, t2);
    }
#endif
    __syncthreads();
    { int tid = F.tid; asm volatile("" : "+v"(tid)); F.tid = tid; F.lane = tid & 63; F.wid = __builtin_amdgcn_readfirstlane(tid >> 6); }
#ifndef NO_GMLP
    const bf16_t* Gw = WSP(const bf16_t, WS_GWS);
    char* WSl = (char*)F.lds; char* VT = WSl + 32768;
    const int fr = F.lane & 15, fq = F.lane >> 4, w = F.wid;
    for (int u = F.bx; u < 576 * 4; u += F.G) {
        const int g = u & 3, ch = u >> 2; const size_t R0 = (size_t)ch * 128;
        __syncthreads();
#pragma unroll
        for (int i = 0; i < 4; ++i) { const int id = F.tid + NT * i, row = id >> 4, c16 = id & 15;
            *(u32x4*)(WSl + KSWZ(row, c16 * 16)) = *(const u32x4*)(Gw + (size_t)g * 16384 + row * 128 + c16 * 8);
            const u32x4 vv = *(const u32x4*)(PB + (R0 + row) * 2048 + 512 + g * 128 + c16 * 8);
            const unsigned wv[4] = {vv.x, vv.y, vv.z, vv.w};
#pragma unroll
            for (int e = 0; e < 8; ++e) { const int d = c16 * 8 + e; const unsigned short hv = (unsigned short)((e & 1) ? (wv[e >> 1] >> 16) : (wv[e >> 1] & 0xffffu));
                *(unsigned short*)(VT + KSWZ(d, row * 2)) = hv; }
        }
        __syncthreads();
        bf16x8 af[4];
#pragma unroll
        for (int k = 0; k < 4; ++k) af[k] = *(const bf16x8*)(WSl + KSWZ(w * 16 + fr, (k * 32 + fq * 8) * 2));
        const int p = w * 16 + fr; const float bsv = F.in[19][g * 128 + p];
        const size_t R = R0 + p;
#pragma unroll
        for (int dt = 0; dt < 8; ++dt) {
            f32x4 acc = {0.f, 0.f, 0.f, 0.f};
#pragma unroll
            for (int k = 0; k < 4; ++k) { const bf16x8 bfr = *(const bf16x8*)(VT + KSWZ(dt * 16 + fr, (k * 32 + fq * 8) * 2)); acc = __builtin_amdgcn_mfma_f32_16x16x32_bf16(bfr, af[k], acc, 0, 0, 0); }
            const int col = g * 128 + dt * 16 + 4 * fq;
            const u32x2 uu = *(const u32x2*)(PB + R * 2048 + col);
            const float o0 = gelu_tanh(bflo(uu.x)) * (acc[0] + bsv), o1 = gelu_tanh(bfhi(uu.x)) * (acc[1] + bsv), o2 = gelu_tanh(bflo(uu.y)) * (acc[2] + bsv), o3 = gelu_tanh(bfhi(uu.y)) * (acc[3] + bsv);
            u32x2 wv; wv.x = cvt_pk_bf16(o0, o1); wv.y = cvt_pk_bf16(o2, o3); *(u32x2*)(AO + R * 1024 + col) = wv;
        }
    }
    __syncthreads();
#endif
}

struct LnDesc { const float* g; const float* b; const float* modn; int sh_off, sc_off; int latent_only; int final_out; int hbnd; int write_xl; };
__device__ __forceinline__ void phase_ln(const Frame& F, const LnDesc& d) {
    const bf16_t* XL = WSP(const bf16_t, WS_XL); bf16_t* H = WSP(bf16_t, WS_HA); bf16_t* HB_ = WSP(bf16_t, WS_R + R_HBND); float* ST = WSP(float, WS_STATS);
    const int total = d.latent_only ? NB * SEQ : NROWS;
    const int gw = F.bx * 8 + F.wid, nw = F.G * 8; const int per = (total + nw - 1) / nw;
    float gg[16], bb[16], sh[16], sc[16]; int curj = -1;
#pragma unroll
    for (int i = 0; i < 2; ++i)
#pragma unroll
        for (int e = 0; e < 8; ++e) { const int c = F.lane * 8 + 512 * i + e; gg[i * 8 + e] = d.g[c]; bb[i * 8 + e] = d.b[c]; sh[i * 8 + e] = 0.f; sc[i * 8 + e] = 0.f; }
    for (int idx0 = gw * per; idx0 < (gw + 1) * per && idx0 < total; idx0 += 4) {
        u32x4 xr[4][2]; int rr[4], rb[4], rs[4];
#pragma unroll
        for (int q = 0; q < 4; ++q) { const int idx = idx0 + q;
            if (d.latent_only) { rb[q] = idx >> 11; rs[q] = 256 + (idx & 2047); rr[q] = rb[q] * SPB + rs[q]; } else { rr[q] = idx; rb[q] = idx / SPB; rs[q] = idx % SPB; }
            const bf16_t* xp = XL + (size_t)rr[q] * 1024 + F.lane * 8;
            xr[q][0] = *(const u32x4*)(xp); xr[q][1] = *(const u32x4*)(xp + 512); }
#pragma unroll
        for (int q = 0; q < 4; ++q) {
            const int r = rr[q], b = rb[q], s = rs[q]; float x[16]; float sum = 0.f;
            unpack8(xr[q][0], x); unpack8(xr[q][1], x + 8);
#pragma unroll
            for (int e = 0; e < 16; ++e) sum += x[e];
#pragma unroll
            for (int o = 1; o < 64; o <<= 1) sum += __shfl_xor(sum, o);
            const float mu = sum * (1.f / 1024.f); float qq = 0.f;
#pragma unroll
            for (int e = 0; e < 16; ++e) { const float dd = x[e] - mu; qq += dd * dd; }
#pragma unroll
            for (int o = 1; o < 64; o <<= 1) qq += __shfl_xor(qq, o);
            const float rstd = rsqrtf(qq * (1.f / 1024.f) + EPSN);
            if (!d.final_out && F.lane == 0) *(f32x2*)(ST + (size_t)r * 2) = (f32x2){mu, rstd};
            int bidx = -1;
            if (d.hbnd && s >= 256) { const int l = s - 256; if ((l & 255) == 255 && l != SEQ - 1) bidx = (b * 7 + (l >> 8)) * 2; else if ((l & 255) == 0 && l != 0) bidx = (b * 7 + (l >> 8) - 1) * 2 + 1; }
            if (!d.final_out) { const int j = s < 256 ? 32 : b;
                if (j != curj) { curj = j;
#pragma unroll
                    for (int i = 0; i < 2; ++i) { const float* mp = d.modn + (size_t)j * 6144 + F.lane * 8 + 512 * i;
                        const f32x4 a0 = *(const f32x4*)(mp + d.sh_off), a1 = *(const f32x4*)(mp + d.sh_off + 4), c0 = *(const f32x4*)(mp + d.sc_off), c1 = *(const f32x4*)(mp + d.sc_off + 4);
#pragma unroll
                        for (int e = 0; e < 4; ++e) { sh[i * 8 + e] = a0[e]; sh[i * 8 + 4 + e] = a1[e]; sc[i * 8 + e] = c0[e]; sc[i * 8 + 4 + e] = c1[e]; } } } }
            float y[16];
#pragma unroll
            for (int e = 0; e < 16; ++e) y[e] = (x[e] - mu) * rstd * gg[e] + bb[e];
            if (d.final_out) {
                float* op = F.out + ((size_t)b * SEQ + (s - 256)) * 1024 + F.lane * 8;
#pragma unroll
                for (int i = 0; i < 2; ++i) { *(f32x4*)(op + 512 * i) = (f32x4){y[i * 8 + 0], y[i * 8 + 1], y[i * 8 + 2], y[i * 8 + 3]}; *(f32x4*)(op + 512 * i + 4) = (f32x4){y[i * 8 + 4], y[i * 8 + 5], y[i * 8 + 6], y[i * 8 + 7]}; }
            } else {
                float h[16];
#pragma unroll
                for (int e = 0; e < 16; ++e) h[e] = y[e] * (sc[e] + 1.f) + sh[e];
#pragma unroll
                for (int i = 0; i < 2; ++i) { const u32x4 w = pack8(h + i * 8); *(u32x4*)(H + (size_t)r * 1024 + F.lane * 8 + 512 * i) = w; if (bidx >= 0) *(u32x4*)(HB_ + (size_t)bidx * 1024 + F.lane * 8 + 512 * i) = w; }
            }
        }
    }
}

#define XB_TMO      128
#define XB_XCNT(j)  (256  + 64 * (j))
#define XB_XSUB(j)  (1280 + 64 * (j))
#define XB_XGEN(j)  (2304 + 64 * (j))
#define XB_TOP      3328
#define XB_TOPGEN   3392
#define XCD_BAR_WORDS 3456
#define XB_SPIN_CAP (1u << 18)

__device__ __forceinline__ unsigned xb_ld(unsigned* p)              { return __hip_atomic_load(p, __ATOMIC_RELAXED, __HIP_MEMORY_SCOPE_AGENT); }
__device__ __forceinline__ unsigned xb_add(unsigned* p, unsigned v) { return __hip_atomic_fetch_add(p, v, __ATOMIC_RELAXED, __HIP_MEMORY_SCOPE_AGENT); }
__device__ __forceinline__ unsigned xb_xcc_id() { return (unsigned)__builtin_amdgcn_s_getreg((3 << 11) | 20) & 0xFu; }
#define XB_SPIN(cond, bar) do { unsigned _sp = 0; while (cond) { __builtin_amdgcn_s_sleep(1); \
    if ((++_sp & 255u) == 0u) { if (xb_ld(&(bar)[XB_TMO])) break; if (_sp > XB_SPIN_CAP) { atomicAdd(&(bar)[XB_TMO], 1u); break; } } } } while (0)

struct XcdBarrier {
    unsigned* bar; unsigned x;
    volatile LAS unsigned* st;
};

__device__ __forceinline__ XcdBarrier xcd_barrier_post(unsigned* bar, volatile LAS unsigned* st) {
    XcdBarrier b; b.bar = bar; b.x = xb_xcc_id(); b.st = st;
    if (threadIdx.x == 0) (void)xb_add(&bar[XB_XCNT(b.x)], 1u);
    return b;
}
__device__ __forceinline__ void xcd_barrier_complete(unsigned* bar, unsigned x, unsigned& nloc, unsigned& nx) {
    const unsigned G = gridDim.x * gridDim.y * gridDim.z;
    unsigned sum, cnt, mine, sp = 0u;
    for (;;) {
        sum = 0u; cnt = 0u; mine = 0u;
#pragma unroll
        for (unsigned j = 0; j < 16; ++j) { const unsigned c = xb_ld(&bar[XB_XCNT(j)]); sum += c; cnt += (c > 0u) ? 1u : 0u; mine = (j == x) ? c : mine; }
        if (sum == G) break;
        __builtin_amdgcn_s_sleep(1);
        if ((++sp & 255u) == 0u) { if (xb_ld(&bar[XB_TMO])) break; if (sp > XB_SPIN_CAP) { atomicAdd(&bar[XB_TMO], 1u); break; } }
    }
    nloc = mine > 0u ? mine : 1u; nx = cnt > 0u ? cnt : 1u;
}

__device__ __forceinline__ void xcd_barrier(const XcdBarrier& b) {
    asm volatile("s_waitcnt vmcnt(0)" ::: "memory");
    __syncthreads();
    if (threadIdx.x == 0) {
        unsigned* bar = b.bar;
        __builtin_amdgcn_s_waitcnt(0);
        unsigned nloc = b.st[0], nx = b.st[1];
        if (nloc == 0u) { xcd_barrier_complete(bar, b.x, nloc, nx); b.st[0] = nloc; b.st[1] = nx; }
        const unsigned old = xb_add(&bar[XB_XSUB(b.x)], 1u);
        const unsigned gen = old / nloc;
        if (old + 1u == (gen + 1u) * nloc) {
            __builtin_amdgcn_fence(__ATOMIC_RELEASE, "agent");
            asm volatile("s_waitcnt vmcnt(0)" ::: "memory");
            const unsigned og = xb_add(&bar[XB_TOP], 1u);
            const unsigned tg = og / nx;
            if (og + 1u == (tg + 1u) * nx) xb_add(&bar[XB_TOPGEN], 1u);
            else XB_SPIN(xb_ld(&bar[XB_TOPGEN]) == tg, bar);
            __builtin_amdgcn_fence(__ATOMIC_ACQUIRE, "agent");
            xb_add(&bar[XB_XGEN(b.x)], 1u);
            asm volatile("s_waitcnt vmcnt(0)" ::: "memory");
        } else {
            XB_SPIN(xb_ld(&bar[XB_XGEN(b.x)]) == gen, bar);
            __builtin_amdgcn_fence(__ATOMIC_ACQUIRE, "agent");
            asm volatile("s_waitcnt vmcnt(0)" ::: "memory");
        }
    }
    __syncthreads();
}


__device__ __forceinline__ void phase_xconv(const Frame& F, const XcdBarrier& xbar) {
    bf16_t* P1 = WSP(bf16_t, WS_R + R_P1);
    const int gw = F.bx * 8 + F.wid, nw = F.G * 8; const int per = NROWS / nw;
    const int ra = gw * per; const int c0 = F.lane * 16;
    bf16_t* base = P1 + 512 + c0;
    const u32x4 z4 = {0u, 0u, 0u, 0u};
    u32x4 win[6][2];
    u32x4 edge[2];
    if (ra > 0) { win[0][0] = *(const u32x4*)(base + (size_t)(ra - 1) * 1536); win[0][1] = *(const u32x4*)(base + (size_t)(ra - 1) * 1536 + 8); } else { win[0][0] = z4; win[0][1] = z4; }
    if (ra + per < NROWS) { edge[0] = *(const u32x4*)(base + (size_t)(ra + per) * 1536); edge[1] = *(const u32x4*)(base + (size_t)(ra + per) * 1536 + 8); } else { edge[0] = z4; edge[1] = z4; }
    asm volatile("" : "+v"(win[0][0]), "+v"(win[0][1]), "+v"(edge[0]), "+v"(edge[1]));
    xcd_barrier(xbar);
    float w0[16], w1[16], w2[16], wb[16];
#pragma unroll
    for (int e = 0; e < 16; ++e) { w0[e] = F.in[24][c0 + e]; w1[e] = F.in[24][1024 + c0 + e]; w2[e] = F.in[24][2048 + c0 + e]; wb[e] = F.in[25][c0 + e]; }
    win[1][0] = *(const u32x4*)(base + (size_t)ra * 1536); win[1][1] = *(const u32x4*)(base + (size_t)ra * 1536 + 8);
#pragma unroll 1
    for (int g4 = 0; g4 < per; g4 += 4) {
        const int r0 = ra + g4;
#pragma unroll
        for (int q = 2; q < 6; ++q) {
            const int rr = r0 + q - 1;
            if (rr < ra + per) { win[q][0] = *(const u32x4*)(base + (size_t)rr * 1536); win[q][1] = *(const u32x4*)(base + (size_t)rr * 1536 + 8); } else { win[q][0] = edge[0]; win[q][1] = edge[1]; }
        }
#pragma unroll
        for (int q = 1; q < 5; ++q) {
            const int r = r0 + q - 1; const int sidx = r % SPB;
            const bool pv = (sidx != 0 && sidx != 256), nv = (sidx != 255 && sidx != SPB - 1);
            float o[16];
#pragma unroll
            for (int hlf = 0; hlf < 2; ++hlf) {
                float pr[8], cu[8], nx[8];
                unpack8(win[q - 1][hlf], pr); unpack8(win[q][hlf], cu); unpack8(win[q + 1][hlf], nx);
#pragma unroll
                for (int e = 0; e < 8; ++e) o[hlf * 8 + e] = silu_f(wb[hlf * 8 + e] + (pv ? w0[hlf * 8 + e] * pr[e] : 0.f) + w1[hlf * 8 + e] * cu[e] + (nv ? w2[hlf * 8 + e] * nx[e] : 0.f));
            }
            *(u32x4*)(base + (size_t)r * 1536) = pack8(o); *(u32x4*)(base + (size_t)r * 1536 + 8) = pack8(o + 8);
        }
        win[0][0] = win[4][0]; win[0][1] = win[4][1]; win[1][0] = win[5][0]; win[1][1] = win[5][1];
    }
}


__device__ __forceinline__ void phase_ssd(const Frame& F) {
    const bf16_t* P1 = WSP(const bf16_t, WS_R + R_P1); const float* DTb = WSP(const float, WS_R + R_DT);
    bf16_t* YF = WSP(bf16_t, WS_R + R_YF); bf16_t* YB = WSP(bf16_t, WS_R + R_YB);
    char* Cm = (char*)F.lds; char* Bm = Cm + 32768; char* BTW = Cm + 65536; char* XT = Cm + 98304; char* HB = Cm + 114688;
    float* dts = (float*)(Cm + 131072); float* acs = dts + 128; float* wts = acs + 128;
    const int fr = F.lane & 15, fq = F.lane >> 4, w = F.wid;
    for (int item = F.bx; item < NB * 16; item += F.G) {
        const int b = item >> 4, hh = (item >> 1) & 7, dir = item & 1, g = hh >> 2;
        const float aneg = -__expf(F.in[27][dir * 8 + hh]); const float dtbias = F.in[26][dir * 8 + hh]; const float dsk = F.in[28][hh];
        const int scgp = F.tid % 40, spblk = F.tid / 40;
        const int sxc = scgp < 8 ? hh * 64 + scgp * 8 : (scgp < 24 ? 512 + g * 128 + (scgp - 8) * 8 : 768 + g * 128 + (scgp - 24) * 8);
        f32x4 hst[4];
#pragma unroll
        for (int i = 0; i < 4; ++i) hst[i] = (f32x4){0.f, 0.f, 0.f, 0.f};
        __syncthreads();
        for (int i = F.tid; i < 16384 / 4; i += NT) ((unsigned*)HB)[i] = 0u;
        for (int step = 0; step < 18; ++step) {
            const int cc = dir ? (step < 2 ? 1 - step : 19 - step) : step;
            const bool isctx = cc < 2; const int s0 = cc * 128; const size_t R0 = (size_t)b * SPB + s0;
            __syncthreads();
            if (w == 7) {
                const int t0 = 2 * F.lane, t1 = t0 + 1; const int p0 = dir ? 127 - t0 : t0, p1 = dir ? 127 - t1 : t1;
                const float d0 = softplus_f(DTb[(R0 + p0) * 16 + dir * 8 + hh] + dtbias), d1 = softplus_f(DTb[(R0 + p1) * 16 + dir * 8 + hh] + dtbias);
                const float v0 = d0 * aneg, v1 = d1 * aneg; const float sp = v0 + v1; float sc = sp;
#pragma unroll
                for (int o = 1; o < 64; o <<= 1) { const float y = __shfl_up(sc, o); if (F.lane >= o) sc += y; }
                const float tot = __shfl(sc, 63); const float pre = sc - sp; const float a0 = pre + v0, a1 = pre + sp;
                dts[t0] = d0; dts[t1] = d1; acs[t0] = a0; acs[t1] = a1; wts[t0] = d0 * __expf(tot - a0); wts[t1] = d1 * __expf(tot - a1);
            }
            const bool act_stg = (F.tid < 320) && !(isctx && scgp >= 24);
#pragma unroll 1
            for (int rd = 0; rd < 2; ++rd) {
                u32x4 outp[8];
                const int p0 = (spblk * 2 + rd) * 8;
                if (act_stg) {
                    const char* rb = (const char*)(P1 + R0 * 1536);
                    const unsigned voff = (unsigned)(p0 * 1536 + 512 + sxc) * 2u;
#pragma unroll
                    for (int i = 0; i < 8; ++i) outp[i] = *(const u32x4*)(rb + i * 3072 + voff);
                }
                if (rd == 0) __syncthreads();
                if (act_stg) {
                    if (scgp >= 8) {
                        char* dstm = (scgp < 24) ? Bm : Cm; const int n = ((scgp < 24) ? (scgp - 8) : (scgp - 24)) * 8;
#pragma unroll
                        for (int i = 0; i < 8; ++i) { const int t = dir ? 127 - (p0 + i) : p0 + i; *(u32x4*)(dstm + KSWZ(t, n * 2)) = outp[i]; }
                    }
                    if (scgp < 24) {
                        char* dstt = (scgp < 8) ? XT : BTW; const int rowb = ((scgp < 8) ? scgp : (scgp - 8)) * 8; const bool scale = scgp >= 8;
                        float wv[8];
#pragma unroll
                        for (int i = 0; i < 8; ++i) { const int t = dir ? 127 - (p0 + i) : p0 + i; wv[i] = scale ? wts[t] : 1.f; }
                        const int tb = dir ? 120 - p0 : p0;
#pragma unroll
                        for (int e = 0; e < 8; ++e) {
                            float v[8];
#pragma unroll
                            for (int i = 0; i < 8; ++i) { const unsigned wd = (e >> 1) == 0 ? outp[i].x : ((e >> 1) == 1 ? outp[i].y : ((e >> 1) == 2 ? outp[i].z : outp[i].w)); v[i] = ((e & 1) ? bfhi(wd) : bflo(wd)) * wv[i]; }
                            u32x4 lo;
                            if (!dir) { lo.x = cvt_pk_bf16(v[0], v[1]); lo.y = cvt_pk_bf16(v[2], v[3]); lo.z = cvt_pk_bf16(v[4], v[5]); lo.w = cvt_pk_bf16(v[6], v[7]); }
                            else      { lo.x = cvt_pk_bf16(v[7], v[6]); lo.y = cvt_pk_bf16(v[5], v[4]); lo.z = cvt_pk_bf16(v[3], v[2]); lo.w = cvt_pk_bf16(v[1], v[0]); }
                            *(u32x4*)(dstt + KSWZ(rowb + e, tb * 2)) = lo;
                            __builtin_amdgcn_sched_barrier(0);
                        }
                    }
                }
            }
            __syncthreads();
            if (!isctx) {
                const int t = w * 16 + fr; const float act = acs[t];
                bf16x8 cf[4];
#pragma unroll
                for (int k = 0; k < 4; ++k) cf[k] = *(const bf16x8*)(Cm + KSWZ(t, (k * 32 + fq * 8) * 2));
                f32x4 mv[8];
#pragma unroll
                for (int st = 0; st < 8; ++st) {
                    f32x4 acc = {0.f, 0.f, 0.f, 0.f};
                    if (st <= w) {
#pragma unroll
                        for (int k = 0; k < 4; ++k) { const bf16x8 bfr = *(const bf16x8*)(Bm + KSWZ(st * 16 + fr, (k * 32 + fq * 8) * 2)); acc = __builtin_amdgcn_mfma_f32_16x16x32_bf16(bfr, cf[k], acc, 0, 0, 0); }
                        const int sb = st * 16 + 4 * fq; const f32x4 as = *(const f32x4*)(acs + sb), ds = *(const f32x4*)(dts + sb);
#pragma unroll
                        for (int r = 0; r < 4; ++r) acc[r] = (sb + r <= t) ? acc[r] * __expf(act - as[r]) * ds[r] : 0.f;
                    }
                    mv[st] = acc;
                }
                __syncthreads();
#pragma unroll
                for (int st = 0; st < 8; ++st) { u32x2 wv; wv.x = cvt_pk_bf16(mv[st][0], mv[st][1]); wv.y = cvt_pk_bf16(mv[st][2], mv[st][3]); *(u32x2*)(Bm + KSWZ(t, (st * 16 + 4 * fq) * 2)) = wv; }
                __syncthreads();
                bf16x8 mf[4];
#pragma unroll
                for (int k = 0; k < 4; ++k) mf[k] = *(const bf16x8*)(Bm + KSWZ(t, (k * 32 + fq * 8) * 2));
                const float eact = __expf(act);
                const int pos = dir ? 127 - t : t; const size_t li = (size_t)b * SEQ + (size_t)(cc - 2) * 128 + pos;
                bf16_t* Y = (dir ? YB : YF) + li * 512 + hh * 64;
#pragma unroll
                for (int pt = 0; pt < 4; ++pt) {
                    f32x4 yd = {0.f, 0.f, 0.f, 0.f}, yo = {0.f, 0.f, 0.f, 0.f};
#pragma unroll
                    for (int k = 0; k < 4; ++k) {
                        const bf16x8 xf = *(const bf16x8*)(XT + KSWZ(pt * 16 + fr, (k * 32 + fq * 8) * 2)); yd = __builtin_amdgcn_mfma_f32_16x16x32_bf16(xf, mf[k], yd, 0, 0, 0);
                        const bf16x8 hf = *(const bf16x8*)(HB + KSWZ(pt * 16 + fr, (k * 32 + fq * 8) * 2)); yo = __builtin_amdgcn_mfma_f32_16x16x32_bf16(hf, cf[k], yo, 0, 0, 0);
                    }
                    float yv[4];
#pragma unroll
                    for (int r = 0; r < 4; ++r) { yv[r] = yd[r] + eact * yo[r]; if (!dir) yv[r] += dsk * bf2f(*(const bf16_t*)(XT + KSWZ(pt * 16 + 4 * fq + r, t * 2))); }
                    u32x2 wv; wv.x = cvt_pk_bf16(yv[0], yv[1]); wv.y = cvt_pk_bf16(yv[2], yv[3]); *(u32x2*)(Y + pt * 16 + 4 * fq) = wv;
                }
            }
            __syncthreads();
            {
                const float dec = __expf(acs[127]); const int ptile = w & 3, nb = (w >> 2) * 4;
                bf16x8 xf[4];
#pragma unroll
                for (int k = 0; k < 4; ++k) xf[k] = *(const bf16x8*)(XT + KSWZ(ptile * 16 + fr, (k * 32 + fq * 8) * 2));
#pragma unroll
                for (int i = 0; i < 4; ++i) { f32x4 acc = hst[i] * dec;
#pragma unroll
                    for (int k = 0; k < 4; ++k) { const bf16x8 bfr = *(const bf16x8*)(BTW + KSWZ((nb + i) * 16 + fr, (k * 32 + fq * 8) * 2)); acc = __builtin_amdgcn_mfma_f32_16x16x32_bf16(bfr, xf[k], acc, 0, 0, 0); }
                    hst[i] = acc;
                    u32x2 wv; wv.x = cvt_pk_bf16(acc[0], acc[1]); wv.y = cvt_pk_bf16(acc[2], acc[3]); *(u32x2*)(HB + KSWZ(ptile * 16 + fr, ((nb + i) * 16 + 4 * fq) * 2)) = wv; }
            }
        }
    }
    __syncthreads();
}

__device__ __forceinline__ void phase_ssdout(const Frame& F) {
    const bf16_t* P1 = WSP(const bf16_t, WS_R + R_P1); const bf16_t* YF = WSP(const bf16_t, WS_R + R_YF); const bf16_t* YB = WSP(const bf16_t, WS_R + R_YB); bf16_t* AO = WSP(bf16_t, WS_HA);
    const int total = NB * SEQ; const int gw = F.bx * 8 + F.wid, nw = F.G * 8; const int per = (total + nw - 1) / nw;
    float gn[8];
#pragma unroll
    for (int e = 0; e < 8; ++e) gn[e] = F.in[29][F.lane * 8 + e];
    for (int idx = gw * per; idx < (gw + 1) * per && idx < total; ++idx) {
        const int b = idx >> 11, l = idx & 2047; const size_t r = (size_t)b * SPB + 256 + l;
        float yf[8], yb[8], z[8], y[8]; unpack8(*(const u32x4*)(YF + (size_t)idx * 512 + F.lane * 8), yf); unpack8(*(const u32x4*)(YB + (size_t)idx * 512 + F.lane * 8), yb); unpack8(*(const u32x4*)(P1 + r * 1536 + F.lane * 8), z);
        float ss = 0.f;
#pragma unroll
        for (int e = 0; e < 8; ++e) { y[e] = (yf[e] + yb[e]) * silu_f(z[e]); ss += y[e] * y[e]; }
#pragma unroll
        for (int o = 1; o < 64; o <<= 1) ss += __shfl_xor(ss, o);
        const float rstd = rsqrtf(ss * (1.f / 512.f) + EPSN);
#pragma unroll
        for (int e = 0; e < 8; ++e) y[e] = y[e] * rstd * gn[e];
        *(u32x4*)(AO + r * 1024 + 512 + F.lane * 8) = pack8(y);
    }
}

constexpr int NPHASE = 22;
#ifndef PHMASK
#define PHMASK 0xFFFFFFFFFFull
#endif
#define PHON(k) ((PHMASK >> (k)) & 1ull)
__device__ __forceinline__ bool sync_after(int ph) { return !(ph == 11); }

__global__ void __launch_bounds__(NT, 2) mega_fwd(Params P) {
    extern __shared__ __attribute__((aligned(16))) unsigned char lds_raw[];
    Frame F; F.wid0 = __builtin_amdgcn_readfirstlane(threadIdx.x >> 6);
    cg::grid_group grid = cg::this_grid();
    volatile LAS unsigned* bst = (volatile LAS unsigned*)((LAS unsigned char*)lds_raw + LDS_BYTES - 16);
    if (threadIdx.x < 4) bst[threadIdx.x] = 0u;
    __syncthreads();
    XcdBarrier xbar = xcd_barrier_post((unsigned*)(P.ws + WS_BAR), bst);
    if (P.ph_hi > 1000) grid.sync();
    const int ph_lo = MK_MULTI ? P.ph_lo : 0, ph_hi = MK_MULTI ? P.ph_hi : NPHASE;
    for (int ph = ph_lo; ph < ph_hi; ++ph) {
#define RF() frame_refresh(F, P.in, P.ws, P.out, lds_raw)
#define MOD (WSP(const float, WS_MOD))
        bool is_gemm = false; pg8::Desc g{};
        if (ph == 0) { if (PHON(0)) { RF(); phase_prep(F); } }
        else if (ph == 1) { if (PHON(1)) { RF(); phase_mod0(F); } }
        else if (ph == 3) { if (PHON(3)) { RF(); phase_post0(F); } }
        else if (ph == 4) { if (PHON(4)) { RF(); phase_attn_gmlp(F); } }
        else if (ph == 6 || ph == 10 || ph == 17 || ph == 21) {
            RF(); LnDesc d{};
            const int layer = (ph >= 17) ? 1 : 0; const int second = (ph == 10 || ph == 21);
            d.g = F.in[second ? 8 : 6] + layer * 1024; d.b = F.in[second ? 9 : 7] + layer * 1024;
            d.latent_only = layer; d.final_out = (ph == 21); d.hbnd = (ph == 6 || ph == 17); d.write_xl = 0;
            if (ph == 6) { d.modn = MOD; d.sh_off = 3072; d.sc_off = 4096; }
            else if (ph == 10) { d.modn = MOD + 33 * 6144; d.sh_off = 0; d.sc_off = 1024; }
            else { d.modn = MOD + 33 * 6144; d.sh_off = 3072; d.sc_off = 4096; }
            if (PHON(6)) phase_ln(F, d);
        }
        else if (ph == 14) { if (PHON(14)) { RF(); phase_ssd(F); } }
        else if (ph == 15) { if (PHON(15)) { RF(); phase_ssdout(F); } }
        else {
            is_gemm = true; RF();
            g.xin = nullptr; g.cin = nullptr; g.DT = nullptr; g.gate = nullptr; g.a_local = 0; g.o_local = 0; g.b0 = 0; g.cw = nullptr; g.cb = nullptr; g.pbnd = nullptr; g.stats = nullptr; g.lng = nullptr; g.lnb = nullptr;
            if (ph == 2) { g.A = WSP(const bf16_t, WS_HA); g.Bt = WSP(const bf16_t, WS_W0IN); g.K = 1024; g.map = pg8::MAP_PLAIN; g.nM = NTILE; g.nN = 8; g.epi = pg8::EPI_BF16; g.perm = 1; g.O = WSP(void, WS_R + R_PB); g.ldc = 2048; }
            else if (ph == 5) { g.A = WSP(const bf16_t, WS_HA); g.Bt = WSP(const bf16_t, WS_W0OUT); g.K = 1024; g.map = pg8::MAP_PLAIN; g.nM = NTILE; g.nN = 4; g.epi = pg8::EPI_RES; g.perm = 1; g.O = WSP(void, WS_XL); g.ldc = 1024;
                g.gate = MOD + 2048; g.xin = F.in[0]; g.cin = F.in[2]; }
            else if (ph == 11) { g.A = WSP(const bf16_t, WS_W1F); g.Bt = WSP(const bf16_t, WS_HA); g.K = 1024; g.map = pg8::MAP_FSWAP; g.nM = 4; g.nN = 256; g.epi = pg8::EPI_BF16; g.perm = 1; g.O = WSP(void, WS_R + R_YT); g.ldc = 4096; }
            else if (ph == 12) { g.A = WSP(const bf16_t, WS_HA); g.Bt = WSP(const bf16_t, WS_W1IN); g.K = 1024; g.map = pg8::MAP_PLAIN; g.nM = NTILE; g.nN = 7; g.epi = pg8::EPI_BF16_DT; g.perm = 1; g.O = WSP(void, WS_R + R_P1); g.ldc = 1536; g.DT = WSP(float, WS_R + R_DT); }
            else if (ph == 13) { g.A = WSP(const bf16_t, WS_DFT); g.Bt = WSP(const bf16_t, WS_R + R_YT); g.K = 4096; g.map = pg8::MAP_DFT; g.nM = 256; g.nN = 2; g.epi = pg8::EPI_BF16; g.perm = 1; g.O = WSP(void, WS_HA); g.ldc = 1024; }
            else if (ph == 16) { g.A = WSP(const bf16_t, WS_HA); g.Bt = WSP(const bf16_t, WS_W1OUT); g.K = 1024; g.map = pg8::MAP_LATENT; g.nM = 256; g.nN = 4; g.epi = pg8::EPI_RES; g.perm = 1; g.O = WSP(void, WS_XL); g.ldc = 1024; g.gate = MOD + 33 * 6144 + 2048;
                g.stats = WSP(const float, WS_STATS); g.lng = F.in[8]; g.lnb = F.in[9]; }
            else {
                const int layer = ph >= 18 ? 1 : 0; const int which = ph - (layer ? 18 : 7);
                g.map = layer ? pg8::MAP_LATENT : pg8::MAP_PLAIN; g.nM = layer ? 256 : NTILE;
                if (which == 0) { g.A = WSP(const bf16_t, WS_R + R_HBND); g.Bt = WSP(const bf16_t, layer ? WS_WUP1 : WS_WUP0); g.K = 1024; g.map = pg8::MAP_RAW; g.nM = 2; g.nN = 22; g.epi = pg8::EPI_BF16; g.perm = 1; g.O = WSP(void, WS_R + R_PBND); g.ldc = DFF2; }
                else if (which == 1) { g.A = WSP(const bf16_t, WS_HA); g.Bt = WSP(const bf16_t, layer ? WS_WUP1 : WS_WUP0); g.K = 1024; g.nN = 22; g.epi = pg8::EPI_UPF; g.perm = 1; g.O = WSP(void, WS_R + R_G); g.ldc = DFF;
                    g.cw = F.in[11] + (size_t)layer * 3 * DFF2; g.cb = F.in[12] + (size_t)layer * DFF2; g.pbnd = WSP(const bf16_t, WS_R + R_PBND); }
                else { g.A = WSP(const bf16_t, WS_R + R_G); g.Bt = WSP(const bf16_t, layer ? WS_WDN1 : WS_WDN0); g.K = DFF; g.nN = 4; g.epi = pg8::EPI_RES; g.perm = 1; g.O = WSP(void, WS_XL); g.ldc = 1024;
                    g.gate = MOD + (size_t)layer * 33 * 6144 + 5120; g.stats = WSP(const float, WS_STATS); g.lng = F.in[6] + layer * 1024; g.lnb = F.in[7] + layer * 1024; }
            }
        }
        if (ph == 13 && PHON(13)) { RF(); phase_xconv(F, xbar); RF(); }
        if (is_gemm && PHON(2)) pg8::gemm_phase((LAS unsigned char*)F.lds, g, F.G, F.bx, F.tid);
        if (ph + 1 < ph_hi && sync_after(ph)) xcd_barrier(xbar);
    }
}

extern "C" void kernel_launch(void* const* d_in, const int* in_sizes, int n_in, void* d_out, int out_size, void* d_ws, size_t ws_size, hipStream_t stream) {
    static int grid = 0;
    if (grid == 0) {
        if (n_in != 30 || ws_size < WS_END) { fprintf(stderr, "kernel_launch: n_in %d ws %zu (need %zu)\n", n_in, ws_size, (size_t)WS_END); grid = -1; return; }
        int dev = 0, cus = 0, per_cu = 0;
        hipGetDevice(&dev); hipDeviceGetAttribute(&cus, hipDeviceAttributeMultiprocessorCount, dev);
        if (hipFuncSetAttribute((const void*)mega_fwd, hipFuncAttributeMaxDynamicSharedMemorySize, LDS_BYTES) != hipSuccess) { fprintf(stderr, "kernel_launch: hipFuncSetAttribute failed\n"); grid = -1; return; }
        hipOccupancyMaxActiveBlocksPerMultiprocessor(&per_cu, (const void*)mega_fwd, NT, LDS_BYTES);
        if (per_cu < 1) { fprintf(stderr, "kernel_launch: occupancy query says %d blocks per CU\n", per_cu); per_cu = 1; }
        (void)hipGetLastError();
        grid = cus * 1;
    }
    if (grid < 0) return;
    Params p{};
    for (int i = 0; i < 30; ++i) p.in[i] = (const float*)d_in[i];
    p.out = (float*)d_out; p.ws = (unsigned char*)d_ws;
#if MK_MULTI
    int lo = 0;
    for (int ph = 0; ph < NPHASE; ++ph) {
        if (ph + 1 == NPHASE || !(ph == 11)) { p.ph_lo = lo; p.ph_hi = ph + 1; lo = ph + 1;
            hipLaunchKernelGGL(mega_fwd, dim3(grid), dim3(NT), LDS_BYTES, stream, p); }
    }
#else
    p.ph_lo = 0; p.ph_hi = NPHASE;
    if (hipMemsetAsync((char*)d_ws + WS_BAR, 0, XCD_BAR_WORDS * sizeof(unsigned), stream) != hipSuccess) { fprintf(stderr, "kernel_launch: hipMemsetAsync failed\n"); return; }
    void* args[] = {&p};
    hipError_t e = hipLaunchCooperativeKernel((const void*)mega_fwd, dim3(grid), dim3(NT), args, LDS_BYTES, stream);
    if (e != hipSuccess) fprintf(stderr, "cooperative launch failed: %s (grid %d)\n", hipGetErrorString(e), grid);
#endif
}
```
